# Optimizing an MI355X kernel written in HIP

```python
import jax, jax.numpy as jnp
from jax import lax
import numpy as np

D_MODEL = 1024
BATCH = 4
SEQ = 8192
DEPTH = 2

LRU_WIDTH = 5 * D_MODEL // 4
LRU_BLOCKS = 16
LRU_BLOCK = LRU_WIDTH // LRU_BLOCKS
CONV_WIDTH = 4
LRU_C = 8.0
RW_HEAD = 64
RW_WIDTH = D_MODEL
RW_HEADS = RW_WIDTH // RW_HEAD
RW_DECAY_LORA = 64
RW_AAA_LORA = 64
RW_MV_LORA = 32
RW_GATE_LORA = 160
RW_LN_EPS = 64e-5
ATT_HEAD = 64
ATT_HEADS = D_MODEL // ATT_HEAD
ATT_KV_HEADS = ATT_HEADS // 4
ATT_GROUP = ATT_HEADS // ATT_KV_HEADS
ATT_WIDTH = ATT_HEADS * ATT_HEAD
KV_WIDTH = ATT_KV_HEADS * ATT_HEAD
WINDOW = 128
BLOCK = 128
D_FF = -(-8 * D_MODEL // (3 * 256)) * 256
N_BRANCH = 3
RMS_EPS = 1e-6
QK_EPS = 1e-6
NEG_INF = -1e30

RW_SIZES = (RW_WIDTH, RW_WIDTH, RW_WIDTH, RW_DECAY_LORA, RW_AAA_LORA, RW_GATE_LORA)
RW_COLS = sum(RW_SIZES)
RW_POINTS = tuple(int(v) for v in np.cumsum(RW_SIZES)[:-1])
IN_SIZES = (LRU_WIDTH, LRU_WIDTH, RW_COLS, ATT_WIDTH, KV_WIDTH, KV_WIDTH, N_BRANCH * D_MODEL)
IN_COLS = sum(IN_SIZES)
IN_POINTS = tuple(int(v) for v in np.cumsum(IN_SIZES)[:-1])

kernel_name = "hybrid_rglru_rwkv7_swa_parallel"


def rms_norm(x):
    xf = x.astype(jnp.float32)
    return (xf * lax.rsqrt(jnp.mean(xf * xf, -1, keepdims=True) + RMS_EPS)).astype(x.dtype)


def shift_right(t):
    return jnp.concatenate([jnp.zeros_like(t[:, :1]), t[:, :-1]], axis=1)


def causal_conv(x, w, b):
    S = x.shape[1]
    K = w.shape[0]
    xp = jnp.pad(x, ((0, 0), (K - 1, 0), (0, 0)))
    out = b
    for j in range(K):
        out = out + xp[:, j:j + S] * w[j]
    return out


def rg_lru(x, w_a, b_a, w_x, b_x, lam):
    B, S, _ = x.shape
    xb = x.reshape(B, S, LRU_BLOCKS, LRU_BLOCK)
    gate_a = jax.nn.sigmoid(jnp.einsum('bsni,nij->bsnj', xb, w_a).reshape(B, S, LRU_WIDTH) + b_a)
    gate_x = jax.nn.sigmoid(jnp.einsum('bsni,nij->bsnj', xb, w_x).reshape(B, S, LRU_WIDTH) + b_x)
    log_a = -LRU_C * gate_a.astype(jnp.float32) * jax.nn.softplus(-lam.astype(jnp.float32))
    a = jnp.exp(log_a)
    mult = jnp.sqrt(1.0 - jnp.exp(2.0 * log_a))
    u = x.astype(jnp.float32) * gate_x.astype(jnp.float32) * mult

    def combine(left, right):
        a_l, b_l = left
        a_r, b_r = right
        return a_l * a_r, a_r * b_l + b_r

    _, h = lax.associative_scan(combine, (a, u), axis=1)
    return h.astype(x.dtype)


def rwkv7_scan(r, w, k, v, a, b):
    B, S, H, N = r.shape

    def step(state, inp):
        r_t, w_t, k_t, v_t, a_t, b_t = inp
        sa = jnp.einsum('bhvk,bhk->bhv', state, a_t)
        state = (state * w_t[:, :, None, :] + sa[..., None] * b_t[:, :, None, :]
                 + v_t[..., None] * k_t[:, :, None, :])
        return state, jnp.einsum('bhvk,bhk->bhv', state, r_t)

    xs = tuple(jnp.moveaxis(t, 1, 0) for t in (r, w, k, v, a, b))
    init = jnp.zeros((B, H, N, N), jnp.float32)
    _, ys = lax.scan(step, init, xs)
    return jnp.moveaxis(ys, 0, 1)


def rwkv7_time_mix(p_rw, mu, w0, w2, a0, a2, g2, k_k, k_a, r_k, ln_w, ln_b, v_first, v_mix):
    B, S, _ = p_rw.shape
    p = p_rw + (shift_right(p_rw) - p_rw) * mu
    r, k, v, wl, al, gl = jnp.split(p, RW_POINTS, axis=-1)
    w = -jax.nn.softplus(-(w0 + jnp.tanh(wl) @ w2)) - 0.5
    a = jax.nn.sigmoid(a0 + al @ a2)
    g = jax.nn.sigmoid(gl) @ g2
    if v_mix is not None:
        v = v + (v_first - v) * v_mix

    def heads(t):
        return t.reshape(B, S, RW_HEADS, RW_HEAD).astype(jnp.float32)

    kk = heads(k * k_k)
    kk = kk * lax.rsqrt(jnp.maximum(jnp.sum(kk * kk, -1, keepdims=True), 1e-24))
    k = k * (1 + (a - 1) * k_a)
    rh, kh, vh, ah = heads(r), heads(k), heads(v), heads(a)
    decay = jnp.exp(-jnp.exp(heads(w)))
    y = rwkv7_scan(rh, decay, kh, vh, -kk, kk * ah)
    mean = jnp.mean(y, -1, keepdims=True)
    var = jnp.mean(jnp.square(y - mean), -1, keepdims=True)
    y = ((y - mean) * lax.rsqrt(var + RW_LN_EPS)).reshape(B, S, RW_WIDTH) * ln_w + ln_b
    r_k_h = r_k.reshape(RW_HEADS, RW_HEAD).astype(jnp.float32)
    bonus = jnp.sum(rh * kh * r_k_h, -1, keepdims=True) * vh
    out = (y + bonus.reshape(B, S, RW_WIDTH)) * g
    return out.astype(p_rw.dtype), v


def head_rms(t, gain):
    tf = t.astype(jnp.float32)
    return (tf * lax.rsqrt(jnp.mean(tf * tf, -1, keepdims=True) + QK_EPS) * gain).astype(t.dtype)


def band(t):
    B, S = t.shape[:2]
    tb = t.reshape((B, S // BLOCK, BLOCK) + t.shape[2:])
    prev = jnp.concatenate([jnp.zeros_like(tb[:, :1]), tb[:, :-1]], axis=1)
    return jnp.concatenate([prev, tb], axis=2)


def sliding_window_attention(q, k, v, q_gain, k_gain, sinks):
    B, S, _ = q.shape
    NB = S // BLOCK
    q = head_rms(q.reshape(B, S, ATT_KV_HEADS, ATT_GROUP, ATT_HEAD), q_gain)
    k = head_rms(k.reshape(B, S, ATT_KV_HEADS, ATT_HEAD), k_gain)
    v = v.reshape(B, S, ATT_KV_HEADS, ATT_HEAD)
    qb = q.reshape(B, NB, BLOCK, ATT_KV_HEADS, ATT_GROUP, ATT_HEAD)
    kb, vb = band(k), band(v)
    s = jnp.einsum('bnqkgd,bnjkd->bkgnqj', qb, kb).astype(jnp.float32) * (ATT_HEAD ** -0.5)
    qi = jnp.arange(BLOCK)[:, None] + BLOCK
    kj = jnp.arange(2 * BLOCK)[None, :]
    local = (kj <= qi) & (qi - kj < WINDOW)
    valid = (jnp.arange(NB)[:, None, None] * BLOCK - BLOCK + kj[None]) >= 0
    mask = local[None] & valid
    s = jnp.where(mask, s, NEG_INF)
    sink = sinks.reshape(ATT_KV_HEADS, ATT_GROUP).astype(jnp.float32)[None, :, :, None, None, None]
    m = jnp.maximum(jnp.max(s, -1, keepdims=True), sink)
    e = jnp.exp(s - m)
    probs = e / (jnp.sum(e, -1, keepdims=True) + jnp.exp(sink - m))
    o = jnp.einsum('bkgnqj,bnjkd->bnqkgd', probs.astype(v.dtype), vb)
    return o.reshape(B, S, ATT_WIDTH)


def swiglu(h, w_in, w_out):
    gate, up = jnp.split(h @ w_in, 2, axis=-1)
    return (jax.nn.silu(gate) * up) @ w_out


def setup_inputs(seed: int = 0) -> dict:
    key = jax.random.key(seed)
    ks = jax.random.split(key, 40)
    f32 = jnp.float32
    L = DEPTH

    def nrm(k, shape, scale):
        return jax.random.normal(k, shape, f32) * scale

    a_init = jax.random.uniform(ks[11], (L, LRU_WIDTH), f32, 0.9, 0.999)
    s_init = a_init ** (1.0 / LRU_C)
    lam = jnp.log(s_init) - jnp.log1p(-s_init)
    return {
        "x": nrm(ks[0], (BATCH, SEQ, D_MODEL), 1.0),
        "c": nrm(ks[1], (BATCH, D_MODEL), 1.0),
        "w_ada": nrm(ks[2], (L, D_MODEL, 6 * D_MODEL), 0.5 * D_MODEL ** -0.5),
        "b_ada": nrm(ks[3], (L, 6 * D_MODEL), 0.02),
        "w_in": nrm(ks[4], (L, D_MODEL, IN_COLS), D_MODEL ** -0.5),
        "conv_w": nrm(ks[5], (L, CONV_WIDTH, LRU_WIDTH), CONV_WIDTH ** -0.5),
        "conv_b": nrm(ks[6], (L, LRU_WIDTH), 0.02),
        "lru_wa": nrm(ks[7], (L, LRU_BLOCKS, LRU_BLOCK, LRU_BLOCK), LRU_BLOCK ** -0.5),
        "lru_ba": nrm(ks[8], (L, LRU_WIDTH), 0.02),
        "lru_wx": nrm(ks[9], (L, LRU_BLOCKS, LRU_BLOCK, LRU_BLOCK), LRU_BLOCK ** -0.5),
        "lru_bx": nrm(ks[10], (L, LRU_WIDTH), 0.02),
        "lru_lambda": lam,
        "w_lru_o": nrm(ks[12], (L, LRU_WIDTH, D_MODEL), LRU_WIDTH ** -0.5),
        "rw_mu": jax.random.uniform(ks[13], (L, RW_COLS), f32),
        "rw_w0": jax.random.uniform(ks[14], (L, RW_WIDTH), f32, -6.0, 0.0),
        "rw_w2": nrm(ks[15], (L, RW_DECAY_LORA, RW_WIDTH), 0.1 * RW_DECAY_LORA ** -0.5),
        "rw_a0": nrm(ks[16], (L, RW_WIDTH), 0.1),
        "rw_a2": nrm(ks[17], (L, RW_AAA_LORA, RW_WIDTH), 0.1 * RW_AAA_LORA ** -0.5),
        "rw_g2": nrm(ks[18], (L, RW_GATE_LORA, RW_WIDTH), RW_GATE_LORA ** -0.5),
        "rw_kk": 0.85 + nrm(ks[19], (L, RW_WIDTH), 0.05),
        "rw_ka": 1.0 + nrm(ks[20], (L, RW_WIDTH), 0.05),
        "rw_rk": nrm(ks[21], (L, RW_WIDTH), 0.1),
        "rw_ln_w": 1.0 + nrm(ks[22], (L, RW_WIDTH), 0.05),
        "rw_ln_b": nrm(ks[23], (L, RW_WIDTH), 0.02),
        "rw_v0": nrm(ks[24], (L - 1, RW_WIDTH), 0.1),
        "rw_v1": nrm(ks[25], (L - 1, D_MODEL, RW_MV_LORA), D_MODEL ** -0.5),
        "rw_v2": nrm(ks[26], (L - 1, RW_MV_LORA, RW_WIDTH), 0.1 * RW_MV_LORA ** -0.5),
        "w_rw_o": nrm(ks[27], (L, RW_WIDTH, D_MODEL), RW_WIDTH ** -0.5),
        "q_gain": 1.0 + nrm(ks[28], (L, ATT_HEAD), 0.05),
        "k_gain": 1.0 + nrm(ks[29], (L, ATT_HEAD), 0.05),
        "sinks": nrm(ks[30], (L, ATT_HEADS), 0.5),
        "w_att_o": nrm(ks[31], (L, ATT_WIDTH, D_MODEL), ATT_WIDTH ** -0.5),
        "w_out": nrm(ks[32], (L, D_MODEL, D_MODEL), D_MODEL ** -0.5),
        "w_ffn_in": nrm(ks[33], (L, D_MODEL, 2 * D_FF), D_MODEL ** -0.5),
        "w_ffn_out": nrm(ks[34], (L, D_FF, D_MODEL), D_FF ** -0.5),
    }


def reference(x, c, w_ada, b_ada, w_in, conv_w, conv_b, lru_wa, lru_ba, lru_wx, lru_bx,
              lru_lambda, w_lru_o, rw_mu, rw_w0, rw_w2, rw_a0, rw_a2, rw_g2, rw_kk, rw_ka,
              rw_rk, rw_ln_w, rw_ln_b, rw_v0, rw_v1, rw_v2, w_rw_o, q_gain, k_gain, sinks,
              w_att_o, w_out, w_ffn_in, w_ffn_out):
    c_act = jax.nn.silu(c)
    v_first = None
    for i in range(DEPTH):
        mod = (c_act @ w_ada[i] + b_ada[i])[:, None, :]
        sh1, sc1, g1, sh2, sc2, g2 = jnp.split(mod, 6, axis=-1)

        h = rms_norm(x) * (1 + sc1) + sh1
        proj = h @ w_in[i]
        lru_x, lru_y, p_rw, q, k, v, gates = jnp.split(proj, IN_POINTS, axis=-1)

        xa = causal_conv(lru_x, conv_w[i], conv_b[i])
        ha = rg_lru(xa, lru_wa[i], lru_ba[i], lru_wx[i], lru_bx[i], lru_lambda[i])
        o_a = (ha * jax.nn.gelu(lru_y)) @ w_lru_o[i]

        if i == 0:
            v_mix = None
        else:
            v_mix = jax.nn.sigmoid(rw_v0[i - 1] + (h @ rw_v1[i - 1]) @ rw_v2[i - 1])
        y_b, v_cur = rwkv7_time_mix(p_rw, rw_mu[i], rw_w0[i], rw_w2[i], rw_a0[i], rw_a2[i],
                                    rw_g2[i], rw_kk[i], rw_ka[i], rw_rk[i], rw_ln_w[i],
                                    rw_ln_b[i], v_first, v_mix)
        if i == 0:
            v_first = v_cur
        o_b = y_b @ w_rw_o[i]

        y_c = sliding_window_attention(q, k, v, q_gain[i], k_gain[i], sinks[i])
        o_c = y_c @ w_att_o[i]

        gate_a, gate_b, gate_c = jnp.split(jax.nn.sigmoid(gates), N_BRANCH, axis=-1)
        mixed = (gate_a * o_a + gate_b * o_b + gate_c * o_c) @ w_out[i]
        x = x + g1 * mixed

        h2 = rms_norm(x) * (1 + sc2) + sh2
        x = x + g2 * swiglu(h2, w_ffn_in[i], w_ffn_out[i])
    return x
```

```cpp
#include <hip/hip_runtime.h>
#include <hip/hip_cooperative_groups.h>
#include <cstdio>
#include <cstdint>
namespace cg = cooperative_groups;

#ifndef COOP
#define COOP 0
#endif
#ifndef PHMASK
#define PHMASK 0xFFFF
#endif
#define PHON(i) ((PHMASK >> (i)) & 1)
#ifndef TSEL
#define TSEL 0xFF
#endif
#define TS(i) ((TSEL >> (i)) & 1)
#ifndef EPIMASK
#define EPIMASK 0xFFFF
#endif
#define EPON(i) ((EPIMASK >> (i)) & 1)

#define LAS __attribute__((address_space(3)))
typedef _Float16 f16;
typedef _Float16 f16x8 __attribute__((ext_vector_type(8)));
typedef _Float16 f16x4 __attribute__((ext_vector_type(4)));
typedef float f32x4 __attribute__((ext_vector_type(4)));

constexpr int NB = 4, SEQ = 8192, DM = 1024, TT = NB * SEQ;
constexpr int SEGT = 2048, NSEG = SEQ / SEGT, MS = NB * SEGT;
constexpr int LRUW = 1280, DFF = 2816, INC = 10528, RWC = 3360;
constexpr int NIN = 11008;
constexpr int NTHR = 512;
constexpr int LDS_BYTES = 155648;

constexpr size_t MiB = 1u << 20;
constexpr size_t OFF_MOD = 0;
constexpr size_t OFF_CONVC = 256 * 1024;
constexpr size_t OFF_RKVC = 384 * 1024;
constexpr size_t OFF_LORAC = 512 * 1024;
constexpr size_t OFF_HC = 640 * 1024;
constexpr size_t OFF_SP = 704 * 1024;
constexpr size_t OFF_STATE = 1 * MiB;
constexpr size_t OFF_W = 2 * MiB;
constexpr size_t OFF_VFIRST = 66 * MiB;
constexpr size_t OFF_KN = 130 * MiB;
constexpr size_t OFF_VT = 146 * MiB;
constexpr size_t OFF_H = 162 * MiB;
constexpr size_t OFF_LRUXY = 178 * MiB;
constexpr size_t OFF_RKV = 218 * MiB;
constexpr size_t OFF_LORAR = 266 * MiB;
constexpr size_t OFF_ALORA = 274 * MiB;
constexpr size_t OFF_Q = 282 * MiB;
constexpr size_t OFF_KVRAW = 298 * MiB;
constexpr size_t OFF_GATES = 306 * MiB;
constexpr size_t OFF_V1O = 354 * MiB;
constexpr size_t OFF_XA = 358 * MiB;
constexpr size_t OFF_LOGA = 378 * MiB;
constexpr size_t OFF_U = 398 * MiB;
constexpr size_t OFF_LD = 418 * MiB;
constexpr size_t OFF_A = 434 * MiB;
constexpr size_t OFF_G = 450 * MiB;
constexpr size_t OFF_VMIX = 466 * MiB;
constexpr size_t OFF_KK = 482 * MiB;
constexpr size_t OFF_R = OFF_H, OFF_K = OFF_LORAR, OFF_V = OFF_XA, OFF_YA = OFF_RKV, OFF_Y = 238 * MiB, OFF_FFH = OFF_LRUXY;
constexpr size_t OFF_MERGED = OFF_LD, OFF_MIXED = OFF_G, OFF_YB = OFF_VMIX;
constexpr size_t WS_END = 498 * MiB;
constexpr size_t W_IN = 0, W_LG = W_IN + (size_t)NIN * 1024, W_LO = W_LG + 2560 * 1280, W_RO = W_LO + 1024 * 1280, W_AO = W_RO + 1024 * 1024, W_OUT = W_AO + 1024 * 1024,
                 W_FI = W_OUT + 1024 * 1024, W_FO = W_FI + 5632 * 1024, W_W2 = W_FO + 1024 * 2816, W_A2 = W_W2 + 1024 * 128, W_G2 = W_A2 + 1024 * 128, W_V2 = W_G2 + 1024 * 256, W_TOT = W_V2 + 1024 * 128;
static_assert(W_TOT * 2 <= 64 * MiB, "weights");

struct Params { const float* in[35]; float* out; unsigned char* ws; int ph_lo, ph_hi; int coop; int pad; };
enum { I_X = 0, I_C, I_WADA, I_BADA, I_WIN, I_CONVW, I_CONVB, I_LRUWA, I_LRUBA, I_LRUWX, I_LRUBX, I_LAM, I_WLRUO, I_MU, I_W0, I_W2, I_A0, I_A2, I_G2, I_KK, I_KA, I_RK, I_LNW, I_LNB,
       I_V0, I_V1, I_V2, I_WRWO, I_QG, I_KG, I_SINK, I_WATTO, I_WOUT, I_WFI, I_WFO };

__device__ __forceinline__ int otid() { int t = threadIdx.x; asm volatile("" : "+v"(t)); return t; }
__device__ __forceinline__ unsigned char* ows(unsigned char* p) { asm volatile("" : "+s"(p)); return p; }
__device__ __forceinline__ float sigm(float x) { return 1.f / (1.f + __expf(-x)); }
__device__ __forceinline__ float wave_sum(float v) {
#pragma unroll
    for (int o = 1; o < 64; o <<= 1) v += __shfl_xor(v, o);
    return v;
}
template <int CTRL> __device__ __forceinline__ float dppf(float x) { return __builtin_bit_cast(float, __builtin_amdgcn_update_dpp(0, __builtin_bit_cast(int, x), CTRL, 0xf, 0xf, false)); }
__device__ __forceinline__ float red16(float x) { x += dppf<0x128>(x); x += dppf<0x124>(x); x += dppf<0x122>(x); x += dppf<0x121>(x); return x; }
__device__ __forceinline__ int grow(int r, int seg) { return (r >> 11) * SEQ + seg * SEGT + (r & (SEGT - 1)); }

namespace pg8 {
constexpr int BM = 256, BK = 64, HALF = 128, HTB = HALF * BK * 2, STAGE_BYTES = 8 * HTB, NXCD = 8, WGM = 8;
__host__ __device__ __forceinline__ int lds_byte(int r, int c) { const int st = (r >> 4) * 2 + (c >> 5), rr = r & 15, cc = c & 31, ob = rr * 64 + cc * 2; return st * 1024 + (ob ^ (((ob >> 9) & 1) << 5)); }
__host__ __device__ __forceinline__ void stage_rc(int b, int& R, int& C) { const int st = b / 1024, sb = b % 1024, swz = sb ^ (((sb >> 9) & 1) << 5); R = (st >> 1) * 16 + swz / 64; C = (st & 1) * 32 + (swz % 64) / 2; }
__host__ __device__ __forceinline__ int perm32(int rho) { const int n = rho >> 4, i = rho & 15; return 8 * (i >> 2) + 4 * n + (i & 3); }
struct Unit { int pm, pn, koff; };
struct Gemm { const f16* A; const f16* Bt; int lda, ldb, nt; };
struct StaticOrder {
    int nM, nN, nwg, G, c, lru;
    __device__ void init(int M, int N, int G_, int c_, int lru_) { nM = M / BM; nN = N / BM; nwg = nM * nN; G = G_; c = c_; lru = lru_; }
    __device__ bool next(int i, Unit& u) const {
        const long L = (long)i * G + c; if (L >= nwg) return false;
        int wgid = (int)L; { const int q = nwg / NXCD, r = nwg % NXCD, xcd = wgid % NXCD, off = wgid / NXCD; wgid = (xcd < r ? xcd * (q + 1) : r * (q + 1) + (xcd - r) * q) + off; }
        const int nig = WGM * nN, gid = wgid / nig, fm = gid * WGM, gsz = (nM - fm) < WGM ? (nM - fm) : WGM;
        u.pm = fm + ((wgid % nig) % gsz); u.pn = (wgid % nig) / gsz; u.koff = 0;
        if (lru) { const int j = u.pn; u.koff = j == 0 ? 0 : j == 1 ? 64 : j == 2 ? 192 : j == 3 ? 320 : j == 4 ? 448 : j == 5 ? 640 : j == 6 ? 704 : j == 7 ? 832 : j == 8 ? 960 : 1024; }
        return true;
    }
};
template <class EpiD>
__device__ __forceinline__ void gemm_phase(LAS unsigned char* lds, const Gemm g, const StaticOrder& S, const EpiD& ED) {
    const int tid = otid(), wid = __builtin_amdgcn_readfirstlane(tid >> 6), lane = tid & 63, wr = wid >> 2, wc = wid & 3, fr = lane & 15, fq = lane >> 4;
    const int nt = g.nt;
    unsigned voffA[2], voffB[2];
#pragma unroll
    for (int i = 0; i < 2; ++i) { int R, C; stage_rc(tid * 16 + i * 8192, R, C); const int Rb = (R & ~31) + perm32(R & 31);
        voffA[i] = (unsigned)(R * g.lda + C) * 2u; voffB[i] = (unsigned)(Rb * g.ldb + C) * 2u; }
    const size_t kstep = (size_t)(BK * 2);
    const size_t hstepA = (size_t)HALF * g.lda * 2, hstepB = (size_t)HALF * g.ldb * 2;
    const unsigned ldsw = (unsigned)wid * 1024u;
    const int aoff = lds_byte(wr * 64 + fr, fq * 8), boff = lds_byte(wc * 32 + fr, fq * 8);
#define PG8_SA(b, h) (((b) * 2 + (h)) * HTB)
#define PG8_SB(b, h) ((4 + (b) * 2 + (h)) * HTB)
#define PG8_STAGE(bufoff, gbase, voff) do { _Pragma("unroll") for (int _i = 0; _i < 2; ++_i) \
        __builtin_amdgcn_global_load_lds((const unsigned*)((const char*)(gbase) + (voff)[_i]), (LAS unsigned*)(lds + (bufoff) + ldsw + _i * 8192), 16, 0, 0); } while (0)
#define PG8_LDA(dst, b, h) do { _Pragma("unroll") for (int m = 0; m < 4; ++m) _Pragma("unroll") for (int k = 0; k < 2; ++k) dst[m][k] = *(const LAS f16x8*)(lds + PG8_SA(b, h) + aoff + m * 2048 + k * 1024); } while (0)
#define PG8_LDB(dst, b, h) do { _Pragma("unroll") for (int n = 0; n < 2; ++n) _Pragma("unroll") for (int k = 0; k < 2; ++k) dst[n][k] = *(const LAS f16x8*)(lds + PG8_SB(b, h) + boff + n * 2048 + k * 1024); } while (0)
#define PG8_MMA(ai, bj, At, Bt) do { __builtin_amdgcn_s_setprio(1); _Pragma("unroll") for (int m = 0; m < 4; ++m) _Pragma("unroll") for (int n = 0; n < 2; ++n) _Pragma("unroll") for (int k = 0; k < 2; ++k) \
        acc[ai][bj][m][n] = __builtin_amdgcn_mfma_f32_16x16x32_f16(Bt[n][k], At[m][k], acc[ai][bj][m][n], 0, 0, 0); __builtin_amdgcn_s_setprio(0); } while (0)
#define PG8_WAIT_V(n) asm volatile("s_waitcnt vmcnt(" #n ")" ::: "memory")
#define PG8_WAIT_L(n) asm volatile("s_waitcnt lgkmcnt(" #n ")" ::: "memory")
#define PG8_BAR __builtin_amdgcn_s_barrier()
#define PG8_SCHED __builtin_amdgcn_sched_barrier(0)
    Unit cur, nxt; int ui = 0;
    if (!S.next(0, cur)) return;
    f32x4 acc[2][2][4][2];
#pragma unroll
    for (int a = 0; a < 2; ++a)
#pragma unroll
        for (int b = 0; b < 2; ++b)
#pragma unroll
            for (int m = 0; m < 4; ++m)
#pragma unroll
                for (int n = 0; n < 2; ++n) acc[a][b][m][n] = (f32x4){0.f, 0.f, 0.f, 0.f};
    f16x8 At[4][2], B0[2][2], B1[2][2];
    const char* cA = (const char*)g.A + (size_t)cur.pm * 2 * hstepA + (size_t)cur.koff * 2; const char* cB = (const char*)g.Bt + (size_t)cur.pn * 2 * hstepB + (size_t)cur.koff * 2;
    PG8_STAGE(PG8_SB(0, 0), cB, voffB); PG8_STAGE(PG8_SB(0, 1), cB + hstepB, voffB); PG8_STAGE(PG8_SA(0, 0), cA, voffA); PG8_STAGE(PG8_SA(0, 1), cA + hstepA, voffA);
    if (wr == 1) PG8_BAR;
    PG8_WAIT_V(2); PG8_BAR;
    PG8_STAGE(PG8_SB(1, 0), cB + kstep, voffB); PG8_STAGE(PG8_SA(1, 0), cA + kstep, voffA); PG8_STAGE(PG8_SB(1, 1), cB + hstepB + kstep, voffB);
    PG8_WAIT_V(6); PG8_BAR;
    for (;;) {
        const bool has_next = S.next(ui + 1, nxt);
        const char* nA = has_next ? (const char*)g.A + (size_t)nxt.pm * 2 * hstepA + (size_t)nxt.koff * 2 : cA; const char* nB = has_next ? (const char*)g.Bt + (size_t)nxt.pn * 2 * hstepB + (size_t)nxt.koff * 2 : cB;
        for (int t = 0; t < nt; t += 2) {
            const bool last = (t == nt - 2);
            const char* a1 = cA + (size_t)(t + 1) * kstep;
            const char* a2 = last ? nA : cA + (size_t)(t + 2) * kstep; const char* b2 = last ? nB : cB + (size_t)(t + 2) * kstep;
            const char* a3 = a2 + kstep; const char* b3 = b2 + kstep;
            PG8_LDB(B0, 0, 0); PG8_LDB(B1, 0, 1); PG8_SCHED; PG8_LDA(At, 0, 0); PG8_STAGE(PG8_SA(1, 1), a1 + hstepA, voffA);
            PG8_WAIT_V(8); PG8_WAIT_L(0); PG8_BAR; PG8_MMA(0, 0, At, B0); PG8_MMA(0, 1, At, B1); PG8_BAR; PG8_SCHED;
            PG8_LDA(At, 0, 1); PG8_STAGE(PG8_SB(0, 0), b2, voffB); PG8_STAGE(PG8_SB(0, 1), b2 + hstepB, voffB); PG8_STAGE(PG8_SA(0, 0), a2, voffA);
            PG8_WAIT_V(8); PG8_WAIT_L(0); PG8_BAR; PG8_MMA(1, 0, At, B0); PG8_MMA(1, 1, At, B1); PG8_BAR; PG8_SCHED;
            PG8_LDB(B0, 1, 0); PG8_LDB(B1, 1, 1); PG8_SCHED; PG8_LDA(At, 1, 0); PG8_STAGE(PG8_SA(0, 1), a2 + hstepA, voffA);
            PG8_WAIT_V(8); PG8_WAIT_L(0); PG8_BAR; PG8_MMA(0, 0, At, B0); PG8_MMA(0, 1, At, B1); PG8_BAR; PG8_SCHED;
            PG8_LDA(At, 1, 1); PG8_STAGE(PG8_SB(1, 0), b3, voffB); PG8_STAGE(PG8_SB(1, 1), b3 + hstepB, voffB); PG8_STAGE(PG8_SA(1, 0), a3, voffA);
            PG8_WAIT_V(8); PG8_WAIT_L(0); PG8_BAR; PG8_MMA(1, 0, At, B0); PG8_MMA(1, 1, At, B1); PG8_BAR; PG8_SCHED;
        }
        if (wr == 0) PG8_BAR;
        ED(acc, cur, wr, wc, fr, fq);
        if (!has_next) break;
#pragma unroll
        for (int a = 0; a < 2; ++a)
#pragma unroll
            for (int b = 0; b < 2; ++b)
#pragma unroll
                for (int m = 0; m < 4; ++m)
#pragma unroll
                    for (int n = 0; n < 2; ++n) acc[a][b][m][n] = (f32x4){0.f, 0.f, 0.f, 0.f};
        cur = nxt; cA = nA; cB = nB; ++ui;
        if (wr == 1) PG8_BAR;
    }
    PG8_WAIT_V(0);
    PG8_BAR;
#undef PG8_SA
#undef PG8_SB
#undef PG8_STAGE
#undef PG8_LDA
#undef PG8_LDB
#undef PG8_MMA
#undef PG8_WAIT_V
#undef PG8_WAIT_L
#undef PG8_BAR
#undef PG8_SCHED
}
}

__device__ __forceinline__ void st8(f16* p, const f32x4& a, const f32x4& b) {
    f16x8 v; v[0] = (f16)a[0]; v[1] = (f16)a[1]; v[2] = (f16)a[2]; v[3] = (f16)a[3]; v[4] = (f16)b[0]; v[5] = (f16)b[1]; v[6] = (f16)b[2]; v[7] = (f16)b[3];
    *(f16x8*)p = v;
}
__device__ __forceinline__ void ld8f(const f16* p, float* o) { const f16x8 v = *(const f16x8*)p;
#pragma unroll
    for (int i = 0; i < 8; ++i) o[i] = (float)v[i]; }
__device__ __forceinline__ void ld8g(const float* p, float* o) { const f32x4 a = *(const f32x4*)p, b = *(const f32x4*)(p + 4); o[0] = a[0]; o[1] = a[1]; o[2] = a[2]; o[3] = a[3]; o[4] = b[0]; o[5] = b[1]; o[6] = b[2]; o[7] = b[3]; }

struct EpiProj {
    unsigned char* ws;
    __device__ __forceinline__ void operator()(int row, int pn, int cin, const f32x4& a0, const f32x4& a1, const f32x4& b0, const f32x4& b1) const {
        size_t off; int ld, ct;
        if (pn < 10) { off = OFF_LRUXY; ld = 2560; ct = pn; } else if (pn < 22) { off = OFF_RKV; ld = 3072; ct = pn - 10; } else if (pn < 24) { off = OFF_LORAR; ld = 512; ct = pn - 22; }
        else if (pn < 28) { off = OFF_Q; ld = 1024; ct = pn - 24; } else if (pn < 30) { off = OFF_KVRAW; ld = 512; ct = pn - 28; } else if (pn < 42) { off = OFF_GATES; ld = 3072; ct = pn - 30; }
        else { off = OFF_V1O; ld = 256; ct = 0; }
        f16* p = (f16*)(ws + off) + (size_t)row * ld + ct * 256 + cin;
        st8(p, a0, a1); st8(p + 128, b0, b1);
    }
};
struct EpiLruGate {
    const f16* xa; f16* loga; f16* u; const float* ba; const float* bx; const float* lam;
    __device__ __forceinline__ void operator()(int row, int pn, int cin, const f32x4& a0, const f32x4& a1, const f32x4& b0, const f32x4& b1) const {
        const int c0 = pn * 128 + cin; float xv[8], bav[8], bxv[8], lv[8];
        ld8f(xa + (size_t)row * LRUW + c0, xv); ld8g(ba + c0, bav); ld8g(bx + c0, bxv); ld8g(lam + c0, lv);
        f16x8 ol, ou;
#pragma unroll
        for (int e = 0; e < 8; ++e) {
            const float pa = (e < 4 ? a0[e & 3] : a1[e & 3]) + bav[e], px = (e < 4 ? b0[e & 3] : b1[e & 3]) + bxv[e];
            const float la = -8.f * sigm(pa) * lv[e];
            const float z = 2.f * la;
            const float em = z > -0.5f ? -z * (1.f + z * (0.5f + z * (0.16666667f + z * (0.041666668f + z * 0.0083333338f)))) : 1.f - __expf(z);
            const float mult = sqrtf(fmaxf(em, 0.f));
            ol[e] = (f16)la; ou[e] = (f16)(xv[e] * sigm(px) * mult);
        }
        *(f16x8*)(loga + (size_t)row * LRUW + c0) = ol; *(f16x8*)(u + (size_t)row * LRUW + c0) = ou;
    }
};
template <int MODE> struct EpiLora {
    f16* O; const float* bias;
    __device__ __forceinline__ void operator()(int row, int pn, int cin, const f32x4& a0, const f32x4& a1, const f32x4& b0, const f32x4& b1) const {
#pragma unroll
        for (int bj = 0; bj < 2; ++bj) {
            const int c0 = pn * 256 + bj * 128 + cin; float bv[8];
            if (MODE != 2) ld8g(bias + c0, bv);
            f16x8 o;
#pragma unroll
            for (int e = 0; e < 8; ++e) {
                const float v = bj == 0 ? (e < 4 ? a0[e & 3] : a1[e & 3]) : (e < 4 ? b0[e & 3] : b1[e & 3]);
                float r;
                if (MODE == 0) { const float z = bv[e] + v; const float sp = (z > 15.f) ? __expf(-z) : __logf(1.f + __expf(-z)); const float w = -sp - 0.5f; r = -__expf(w); }
                else if (MODE == 1) r = sigm(bv[e] + v);
                else r = v;
                o[e] = (f16)r;
            }
            *(f16x8*)(O + (size_t)row * 1024 + c0) = o;
        }
    }
};
template <int BR> struct EpiMerge {
    const f16* gates; float* merged; f16* mixed;
    __device__ __forceinline__ void operator()(int row, int pn, int cin, const f32x4& a0, const f32x4& a1, const f32x4& b0, const f32x4& b1) const {
#pragma unroll
        for (int bj = 0; bj < 2; ++bj) {
            const int c0 = pn * 256 + bj * 128 + cin; float gv[8], mv[8];
            ld8f(gates + (size_t)row * 3072 + BR * 1024 + c0, gv);
            float* mp = merged + (size_t)row * 1024 + c0;
            if (BR > 0) ld8g(mp, mv);
            float o[8];
#pragma unroll
            for (int e = 0; e < 8; ++e) {
                const float v = bj == 0 ? (e < 4 ? a0[e & 3] : a1[e & 3]) : (e < 4 ? b0[e & 3] : b1[e & 3]);
                o[e] = (BR > 0 ? mv[e] : 0.f) + sigm(gv[e]) * v;
            }
            if (BR < 2) { *(f32x4*)mp = (f32x4){o[0], o[1], o[2], o[3]}; *(f32x4*)(mp + 4) = (f32x4){o[4], o[5], o[6], o[7]}; }
            else { f16x8 h;
#pragma unroll
                for (int e = 0; e < 8; ++e) h[e] = (f16)o[e];
                *(f16x8*)(mixed + (size_t)row * 1024 + c0) = h; }
        }
    }
};
struct EpiResid {
    const float* xin; float* out; const float* gate  ; int seg;
    __device__ __forceinline__ void operator()(int row, int pn, int cin, const f32x4& a0, const f32x4& a1, const f32x4& b0, const f32x4& b1) const {
        const size_t g = (size_t)grow(row, seg); const int b = row >> 11;
#pragma unroll
        for (int bj = 0; bj < 2; ++bj) {
            const int c0 = pn * 256 + bj * 128 + cin; float xv[8], gv[8];
            ld8g(xin + g * 1024 + c0, xv); ld8g(gate + b * 6144 + c0, gv);
            float o[8];
#pragma unroll
            for (int e = 0; e < 8; ++e) { const float v = bj == 0 ? (e < 4 ? a0[e & 3] : a1[e & 3]) : (e < 4 ? b0[e & 3] : b1[e & 3]); o[e] = xv[e] + gv[e] * v; }
            float* op = out + g * 1024 + c0;
            *(f32x4*)op = (f32x4){o[0], o[1], o[2], o[3]}; *(f32x4*)(op + 4) = (f32x4){o[4], o[5], o[6], o[7]};
        }
    }
};
struct EpiSwiglu {
    f16* ffh;
    __device__ __forceinline__ void operator()(int row, int pn, int cin, const f32x4& a0, const f32x4& a1, const f32x4& b0, const f32x4& b1) const {
        f16x8 o;
#pragma unroll
        for (int e = 0; e < 8; ++e) { const float gt = e < 4 ? a0[e & 3] : a1[e & 3], up = e < 4 ? b0[e & 3] : b1[e & 3]; o[e] = (f16)(gt * sigm(gt) * up); }
        *(f16x8*)(ffh + (size_t)row * DFF + pn * 128 + cin) = o;
    }
};
struct EpiDispatch {
    int kind; const Params& P; int l, seg;
    template <class E> __device__ __forceinline__ void run(const E& e, const f32x4 (&acc)[2][2][4][2], const pg8::Unit& u, int wr, int wc, int fr, int fq) const {
#pragma unroll
        for (int ai = 0; ai < 2; ++ai)
#pragma unroll
            for (int m = 0; m < 4; ++m) {
                const int row = u.pm * 256 + ai * 128 + wr * 64 + m * 16 + fr;
                __builtin_amdgcn_sched_barrier(0);
                e(row, u.pn, wc * 32 + 8 * fq, acc[ai][0][m][0], acc[ai][0][m][1], acc[ai][1][m][0], acc[ai][1][m][1]);
            }
    }
    __device__ __forceinline__ void operator()(const f32x4 (&acc)[2][2][4][2], const pg8::Unit& u, int wr, int wc, int fr, int fq) const {
        unsigned char* ws = ows(P.ws); const float* const* in = P.in; float* out = P.out; const float* xin = l == 0 ? P.in[I_X] : P.out; const float* mod = (const float*)(ws + OFF_MOD) + (size_t)l * 4 * 6144;
        const f16* gates = (const f16*)(ws + OFF_GATES); float* merged = (float*)(ws + OFF_MERGED); f16* mixed = (f16*)(ws + OFF_MIXED);
        switch (kind) {
        case 0: if (EPON(0)) run(EpiProj{ws}, acc, u, wr, wc, fr, fq); break;
        case 1: if (EPON(1)) run(EpiLruGate{(const f16*)(ws + OFF_XA), (f16*)(ws + OFF_LOGA), (f16*)(ws + OFF_U), in[I_LRUBA] + l * 1280, in[I_LRUBX] + l * 1280, (const float*)(ws + OFF_SP) + l * 1280}, acc, u, wr, wc, fr, fq); break;
        case 2: if (EPON(2)) run(EpiLora<0>{(f16*)(ws + OFF_LD), in[I_W0] + l * 1024}, acc, u, wr, wc, fr, fq); break;
        case 3: if (EPON(3)) run(EpiLora<1>{(f16*)(ws + OFF_A), in[I_A0] + l * 1024}, acc, u, wr, wc, fr, fq); break;
        case 4: if (EPON(4)) run(EpiLora<2>{(f16*)(ws + OFF_G), nullptr}, acc, u, wr, wc, fr, fq); break;
        case 5: if (EPON(5)) run(EpiLora<1>{(f16*)(ws + OFF_VMIX), in[I_V0]}, acc, u, wr, wc, fr, fq); break;
        case 6: if (EPON(6)) run(EpiMerge<0>{gates, merged, mixed}, acc, u, wr, wc, fr, fq); break;
        case 7: if (EPON(7)) run(EpiMerge<1>{gates, merged, mixed}, acc, u, wr, wc, fr, fq); break;
        case 8: if (EPON(8)) run(EpiMerge<2>{gates, merged, mixed}, acc, u, wr, wc, fr, fq); break;
        case 9: if (EPON(9)) run(EpiResid{xin, out, mod + 2048, seg}, acc, u, wr, wc, fr, fq); break;
        case 10: if (EPON(10)) run(EpiSwiglu{(f16*)(ws + OFF_FFH)}, acc, u, wr, wc, fr, fq); break;
        default: if (EPON(11)) run(EpiResid{out, out, mod + 5120, seg}, acc, u, wr, wc, fr, fq); break;
        }
    }
};

template <class Src> __device__ __forceinline__ void prep_w(f16* Wt, int N, int K, const Src& src, float* tile) {
    const int tid = otid(), nkt = K / 64, ntile = (N / 64) * nkt;
    for (int t = blockIdx.x; t < ntile; t += gridDim.x) {
        const int n0 = (t / nkt) * 64, k0 = (t % nkt) * 64;
#pragma unroll
        for (int i = 0; i < 8; ++i) { const int kk = (tid >> 6) + 8 * i, nn = tid & 63; tile[kk * 65 + nn] = src(n0 + nn, k0 + kk); }
        __syncthreads();
#pragma unroll
        for (int i = 0; i < 8; ++i) { const int nn = (tid >> 6) + 8 * i, kk = tid & 63; Wt[(size_t)(n0 + nn) * K + k0 + kk] = (f16)tile[kk * 65 + nn]; }
        __syncthreads();
    }
}

__device__ __forceinline__ void phase_prep(const Params& P, int l, float* tile) {
    f16* W = (f16*)(P.ws + OFF_W);
    { const float* w = P.in[I_WIN] + (size_t)l * 1024 * INC; const float* v1 = P.in[I_V1];
      prep_w(W + W_IN, l == 0 ? 10752 : NIN, 1024, [=](int n, int k) -> float {
          int s;
          if (n < 5632) s = n;
          else if (n < 6144) { const int j = n - 5632; s = j < 64 ? 5632 + j : (j >= 128 && j < 192) ? 5696 + (j - 128) : (j >= 256 && j < 416) ? 5760 + (j - 256) : -1; }
          else if (n < 7168) s = 5920 + (n - 6144);
          else if (n < 7680) s = 6944 + (n - 7168);
          else if (n < 10752) s = 7456 + (n - 7680);
          else { const int j = n - 10752; return j < 32 ? v1[(size_t)k * 32 + j] : 0.f; }
          return s < 0 ? 0.f : w[(size_t)k * INC + s]; }, tile); }
    { const float* wa = P.in[I_LRUWA] + (size_t)l * 16 * 6400; const float* wx = P.in[I_LRUWX] + (size_t)l * 16 * 6400;
      prep_w(W + W_LG, 2560, 1280, [=](int n, int k) -> float {
          const int half = (n & 255) >> 7, c = (n >> 8) * 128 + (n & 127), nb = c / 80, jj = c - nb * 80, kb = k / 80, ii = k - kb * 80;
          if (kb != nb) return 0.f;
          return (half ? wx : wa)[(size_t)(nb * 80 + ii) * 80 + jj]; }, tile); }
    { const float* w = P.in[I_WLRUO] + (size_t)l * 1280 * 1024; prep_w(W + W_LO, 1024, 1280, [=](int n, int k) -> float { return w[(size_t)k * 1024 + n]; }, tile); }
    { const float* w = P.in[I_WRWO] + (size_t)l * 1024 * 1024; prep_w(W + W_RO, 1024, 1024, [=](int n, int k) -> float { return w[(size_t)k * 1024 + n]; }, tile); }
    { const float* w = P.in[I_WATTO] + (size_t)l * 1024 * 1024; prep_w(W + W_AO, 1024, 1024, [=](int n, int k) -> float { return w[(size_t)k * 1024 + n]; }, tile); }
    { const float* w = P.in[I_WOUT] + (size_t)l * 1024 * 1024; prep_w(W + W_OUT, 1024, 1024, [=](int n, int k) -> float { return w[(size_t)k * 1024 + n]; }, tile); }
    { const float* w = P.in[I_WFI] + (size_t)l * 1024 * 5632;
      prep_w(W + W_FI, 5632, 1024, [=](int n, int k) -> float { const int half = (n & 255) >> 7, idx = (n >> 8) * 128 + (n & 127); return w[(size_t)k * 5632 + half * 2816 + idx]; }, tile); }
    { const float* w = P.in[I_WFO] + (size_t)l * 2816 * 1024; prep_w(W + W_FO, 1024, 2816, [=](int n, int k) -> float { return w[(size_t)k * 1024 + n]; }, tile); }
    { const float* w = P.in[I_W2] + (size_t)l * 64 * 1024; prep_w(W + W_W2, 1024, 128, [=](int n, int k) -> float { return k < 64 ? w[(size_t)k * 1024 + n] : 0.f; }, tile); }
    { const float* w = P.in[I_A2] + (size_t)l * 64 * 1024; prep_w(W + W_A2, 1024, 128, [=](int n, int k) -> float { return k < 64 ? w[(size_t)k * 1024 + n] : 0.f; }, tile); }
    { const float* w = P.in[I_G2] + (size_t)l * 160 * 1024; prep_w(W + W_G2, 1024, 256, [=](int n, int k) -> float { return k < 160 ? w[(size_t)k * 1024 + n] : 0.f; }, tile); }
    if (l == 1) { const float* w = P.in[I_V2]; prep_w(W + W_V2, 1024, 128, [=](int n, int k) -> float { return k < 32 ? w[(size_t)k * 1024 + n] : 0.f; }, tile); }
}

__device__ __forceinline__ void phase_mod(const Params& P, float* lds) {
    const int tid = otid(), wave = tid >> 6, lane = tid & 63;
    float* sc = lds;
    float* red = lds + 4096;
    const float* c = P.in[I_C];
    for (int i = tid; i < 4096; i += NTHR) { const float v = c[i]; sc[i] = v * sigm(v); }
    __syncthreads();
    float* mod = (float*)(P.ws + OFF_MOD);
    if (blockIdx.x == 0) for (int i = tid; i < 2560; i += NTHR) ((float*)(P.ws + OFF_SP))[i] = log1pf(expf(-P.in[I_LAM][i]));
    for (int it = blockIdx.x; it < 192; it += gridDim.x) {
        const int l = it / 96, n = (it % 96) * 64 + lane;
        const float* w = P.in[I_WADA] + (size_t)l * 1024 * 6144 + n;
        float a0 = 0.f, a1 = 0.f, a2 = 0.f, a3 = 0.f;
        for (int k = wave * 128; k < wave * 128 + 128; ++k) { const float wv = w[(size_t)k * 6144]; a0 += sc[k] * wv; a1 += sc[1024 + k] * wv; a2 += sc[2048 + k] * wv; a3 += sc[3072 + k] * wv; }
        red[(wave * 4 + 0) * 64 + lane] = a0; red[(wave * 4 + 1) * 64 + lane] = a1; red[(wave * 4 + 2) * 64 + lane] = a2; red[(wave * 4 + 3) * 64 + lane] = a3;
        __syncthreads();
        if (tid < 256) { const int b = tid >> 6; float s = P.in[I_BADA][l * 6144 + n];
#pragma unroll
            for (int w8 = 0; w8 < 8; ++w8) s += red[(w8 * 4 + b) * 64 + lane];
            mod[(size_t)(l * 4 + b) * 6144 + n] = s; }
        __syncthreads();
    }
}

__device__ __forceinline__ void phase_norm(const Params& P, const float* xin, int l, int seg, int which  ) {
    const int tid = otid(), lane = tid & 63, gw = blockIdx.x * 8 + (tid >> 6), nw = gridDim.x * 8;
    f16* H = (f16*)(P.ws + OFF_H);
    for (int r = gw; r < MS; r += nw) {
        const size_t g = (size_t)grow(r, seg); const int b = r >> 11;
        const float* mod = (const float*)(P.ws + OFF_MOD) + (size_t)(l * 4 + b) * 6144 + which * 3072;
        f32x4 v[4]; float ss = 0.f;
#pragma unroll
        for (int i = 0; i < 4; ++i) { v[i] = *(const f32x4*)(xin + g * 1024 + i * 256 + lane * 4); ss += v[i][0] * v[i][0] + v[i][1] * v[i][1] + v[i][2] * v[i][2] + v[i][3] * v[i][3]; }
        ss = wave_sum(ss);
        const float rs = rsqrtf(ss * (1.f / 1024.f) + 1e-6f);
#pragma unroll
        for (int i = 0; i < 4; ++i) { const int c = i * 256 + lane * 4; const f32x4 sh = *(const f32x4*)(mod + c), scl = *(const f32x4*)(mod + 1024 + c); f16x4 o;
#pragma unroll
            for (int e = 0; e < 4; ++e) o[e] = (f16)(v[i][e] * rs * (1.f + scl[e]) + sh[e]);
            *(f16x4*)(H + (size_t)r * 1024 + c) = o; }
    }
}

__device__ __forceinline__ void phase_elem(const Params& P, int l, int seg) {
    const int tid = otid(), lane = tid & 63, gt = blockIdx.x * NTHR + tid, ntot = gridDim.x * NTHR, gw = blockIdx.x * 8 + (tid >> 6), nw = gridDim.x * 8;
    unsigned char* ws = ows(P.ws);
    { const f16* X = (const f16*)(ws + OFF_LRUXY); f16* XA = (f16*)(ws + OFF_XA); f16* cw = (f16*)(ws + OFF_CONVC) + (size_t)(seg & 1) * 4 * 3 * 1280; const f16* cr = (const f16*)(ws + OFF_CONVC) + (size_t)((seg + 1) & 1) * 4 * 3 * 1280;
      const float* w = P.in[I_CONVW] + (size_t)l * 4 * 1280; const float* bia = P.in[I_CONVB] + (size_t)l * 1280;
      for (int it = gt; it < MS * 160; it += ntot) {
          const int r = it / 160, c0 = (it % 160) * 8, b = r >> 11, tl = r & 2047;
          float o[8]; ld8g(bia + c0, o);
#pragma unroll
          for (int j = 0; j < 4; ++j) {
              const int t2 = tl - 3 + j; float xv[8];
              if (t2 >= 0) ld8f(X + (size_t)(r - 3 + j) * 2560 + c0, xv);
              else if (seg > 0) ld8f(cr + (size_t)(b * 3 + (3 + t2)) * 1280 + c0, xv);
              else {
#pragma unroll
                  for (int e = 0; e < 8; ++e) xv[e] = 0.f; }
              float wv[8]; ld8g(w + j * 1280 + c0, wv);
#pragma unroll
              for (int e = 0; e < 8; ++e) o[e] += xv[e] * wv[e];
          }
          f16x8 h;
#pragma unroll
          for (int e = 0; e < 8; ++e) h[e] = (f16)o[e];
          *(f16x8*)(XA + (size_t)r * 1280 + c0) = h;
          if (tl >= SEGT - 3) *(f16x8*)(cw + (size_t)(b * 3 + (tl - (SEGT - 3))) * 1280 + c0) = *(const f16x8*)(X + (size_t)r * 2560 + c0);
      } }
    { const f16* X = (const f16*)(ws + OFF_LORAR); f16* AL = (f16*)(ws + OFF_ALORA); f16* cw = (f16*)(ws + OFF_LORAC) + (size_t)(seg & 1) * 4 * 512; const f16* cr = (const f16*)(ws + OFF_LORAC) + (size_t)((seg + 1) & 1) * 4 * 512;
      const float* mu = P.in[I_MU] + (size_t)l * RWC;
      for (int it = gt; it < MS * 64; it += ntot) {
          const int r = it >> 6, c0 = (it & 63) * 8, b = r >> 11, tl = r & 2047;
          const f16x8 raw = *(const f16x8*)(X + (size_t)r * 512 + c0);
          if (tl == SEGT - 1) *(f16x8*)(cw + b * 512 + c0) = raw;
          int mode, mo;
          if (c0 < 64) { mode = 0; mo = 3072 + c0; } else if (c0 >= 128 && c0 < 192) { mode = 1; mo = 3136 + (c0 - 128); } else if (c0 >= 256 && c0 < 416) { mode = 2; mo = 3200 + (c0 - 256); } else { mode = 3; mo = 0; }
          f16x8 o;
          if (mode == 3) {
#pragma unroll
              for (int e = 0; e < 8; ++e) o[e] = (f16)0.f;
          } else {
              float pv[8];
              if (tl > 0) ld8f(X + (size_t)(r - 1) * 512 + c0, pv);
              else if (seg > 0) ld8f(cr + b * 512 + c0, pv);
              else {
#pragma unroll
                  for (int e = 0; e < 8; ++e) pv[e] = 0.f; }
              float mv[8]; ld8g(mu + mo, mv);
#pragma unroll
              for (int e = 0; e < 8; ++e) { const float x = (float)raw[e]; const float p = x + (pv[e] - x) * mv[e]; o[e] = (f16)(mode == 0 ? tanhf(p) : mode == 1 ? p : sigm(p)); }
          }
          *(f16x8*)(AL + (size_t)r * 512 + c0) = o;
      } }
    { f16* Q = (f16*)(ws + OFF_Q); const f16* KV = (const f16*)(ws + OFF_KVRAW); f16* KN = (f16*)(ws + OFF_KN);
      const float* qg = P.in[I_QG] + l * 64; const float* kg = P.in[I_KG] + l * 64;
      for (int r = gw; r < MS; r += nw) {
          float v[16]; ld8f(Q + (size_t)r * 1024 + lane * 16, v); ld8f(Q + (size_t)r * 1024 + lane * 16 + 8, v + 8);
          float ss = 0.f;
#pragma unroll
          for (int e = 0; e < 16; ++e) ss += v[e] * v[e];
          ss += __shfl_xor(ss, 1); ss += __shfl_xor(ss, 2);
          const float rs = rsqrtf(ss * (1.f / 64.f) + 1e-6f) * 0.125f;
          float gv[16]; ld8g(qg + (lane & 3) * 16, gv); ld8g(qg + (lane & 3) * 16 + 8, gv + 8);
          f16x8 o0, o1;
#pragma unroll
          for (int e = 0; e < 8; ++e) { o0[e] = (f16)(v[e] * rs * gv[e]); o1[e] = (f16)(v[8 + e] * rs * gv[8 + e]); }
          *(f16x8*)(Q + (size_t)r * 1024 + lane * 16) = o0; *(f16x8*)(Q + (size_t)r * 1024 + lane * 16 + 8) = o1;
          const f16x4 kr = *(const f16x4*)(KV + (size_t)r * 512 + lane * 4);
          float kv[4] = {(float)kr[0], (float)kr[1], (float)kr[2], (float)kr[3]};
          float s2 = kv[0] * kv[0] + kv[1] * kv[1] + kv[2] * kv[2] + kv[3] * kv[3];
          s2 += __shfl_xor(s2, 1); s2 += __shfl_xor(s2, 2); s2 += __shfl_xor(s2, 4); s2 += __shfl_xor(s2, 8);
          const float rk = rsqrtf(s2 * (1.f / 64.f) + 1e-6f);
          const f32x4 kgv = *(const f32x4*)(kg + (lane & 15) * 4);
          f16x4 ko; ko[0] = (f16)(kv[0] * rk * kgv[0]); ko[1] = (f16)(kv[1] * rk * kgv[1]); ko[2] = (f16)(kv[2] * rk * kgv[2]); ko[3] = (f16)(kv[3] * rk * kgv[3]);
          *(f16x4*)(KN + (size_t)grow(r, seg) * 256 + lane * 4) = ko;
      } }
    { const f16* KV = (const f16*)(ws + OFF_KVRAW); f16* VT = (f16*)(ws + OFF_VT);
      for (int it = gw; it < (MS / 64) * 4; it += nw) {
          const int tile = it >> 2, kvh = it & 3, r0 = tile * 64, b = r0 >> 11, pos0 = seg * SEGT + (r0 & 2047);
          f16x8 vv[8];
#pragma unroll
          for (int i = 0; i < 8; ++i)
#pragma unroll
              for (int e = 0; e < 8; ++e) vv[i][e] = KV[(size_t)(r0 + i * 8 + e) * 512 + 256 + kvh * 64 + lane];
          f16* dst = VT + ((size_t)((b * 4 + kvh) * 64 + lane)) * SEQ + pos0;
#pragma unroll
          for (int i = 0; i < 8; ++i) *(f16x8*)(dst + i * 8) = vv[i];
      } }
}

__device__ __forceinline__ void phase_rwprep(const Params& P, int l, int seg) {
    const int tid = otid(), lane = tid & 63, gw = blockIdx.x * 8 + (tid >> 6), nw = gridDim.x * 8;
    unsigned char* ws = ows(P.ws);
    const f16* X = (const f16*)(ws + OFF_RKV); const f16* A = (const f16*)(ws + OFF_A); const f16* VM = (const f16*)(ws + OFF_VMIX); f16* VF = (f16*)(ws + OFF_VFIRST);
    f16* R = (f16*)(ws + OFF_R); f16* K = (f16*)(ws + OFF_K); f16* V = (f16*)(ws + OFF_V); f16* KK = (f16*)(ws + OFF_KK);
    f16* cw = (f16*)(ws + OFF_RKVC) + (size_t)(seg & 1) * 4 * 3072; const f16* cr = (const f16*)(ws + OFF_RKVC) + (size_t)((seg + 1) & 1) * 4 * 3072;
    const float* mu = P.in[I_MU] + (size_t)l * RWC; const float* kkw = P.in[I_KK] + l * 1024; const float* kaw = P.in[I_KA] + l * 1024;
    for (int r = gw; r < MS; r += nw) {
        const int b = r >> 11, tl = r & 2047, c = lane * 16; const size_t g = (size_t)grow(r, seg);
        float x[3][16];
#pragma unroll
        for (int j = 0; j < 3; ++j) {
            const f16x8 r0 = *(const f16x8*)(X + (size_t)r * 3072 + j * 1024 + c), r1 = *(const f16x8*)(X + (size_t)r * 3072 + j * 1024 + c + 8);
            if (tl == SEGT - 1) { *(f16x8*)(cw + b * 3072 + j * 1024 + c) = r0; *(f16x8*)(cw + b * 3072 + j * 1024 + c + 8) = r1; }
            float pv[16];
            if (tl > 0) { ld8f(X + (size_t)(r - 1) * 3072 + j * 1024 + c, pv); ld8f(X + (size_t)(r - 1) * 3072 + j * 1024 + c + 8, pv + 8); }
            else if (seg > 0) { ld8f(cr + b * 3072 + j * 1024 + c, pv); ld8f(cr + b * 3072 + j * 1024 + c + 8, pv + 8); }
            else {
#pragma unroll
                for (int e = 0; e < 16; ++e) pv[e] = 0.f; }
            float mv[16]; ld8g(mu + j * 1024 + c, mv); ld8g(mu + j * 1024 + c + 8, mv + 8);
#pragma unroll
            for (int e = 0; e < 16; ++e) { const float xv = e < 8 ? (float)r0[e & 7] : (float)r1[e & 7]; x[j][e] = xv + (pv[e] - xv) * mv[e]; }
        }
        if (l == 0) { f16x8 o0, o1;
#pragma unroll
            for (int e = 0; e < 8; ++e) { o0[e] = (f16)x[2][e]; o1[e] = (f16)x[2][8 + e]; }
            *(f16x8*)(VF + g * 1024 + c) = o0; *(f16x8*)(VF + g * 1024 + c + 8) = o1;
        } else { float vf[16], vm[16]; ld8f(VF + g * 1024 + c, vf); ld8f(VF + g * 1024 + c + 8, vf + 8); ld8f(VM + (size_t)r * 1024 + c, vm); ld8f(VM + (size_t)r * 1024 + c + 8, vm + 8);
#pragma unroll
            for (int e = 0; e < 16; ++e) x[2][e] = x[2][e] + (vf[e] - x[2][e]) * vm[e]; }
        float av[16], kkv[16], kav[16], kk[16];
        ld8f(A + (size_t)r * 1024 + c, av); ld8f(A + (size_t)r * 1024 + c + 8, av + 8);
        ld8g(kkw + c, kkv); ld8g(kkw + c + 8, kkv + 8); ld8g(kaw + c, kav); ld8g(kaw + c + 8, kav + 8);
        float ss = 0.f;
#pragma unroll
        for (int e = 0; e < 16; ++e) { kk[e] = x[1][e] * kkv[e]; ss += kk[e] * kk[e]; }
        ss += __shfl_xor(ss, 1); ss += __shfl_xor(ss, 2);
        const float rn = rsqrtf(fmaxf(ss, 1e-24f));
        f16x8 oR0, oR1, oK0, oK1, oV0, oV1, oQ0, oQ1;
#pragma unroll
        for (int e = 0; e < 8; ++e) {
            oR0[e] = (f16)x[0][e]; oR1[e] = (f16)x[0][8 + e];
            oK0[e] = (f16)(x[1][e] * (1.f + (av[e] - 1.f) * kav[e])); oK1[e] = (f16)(x[1][8 + e] * (1.f + (av[8 + e] - 1.f) * kav[8 + e]));
            oV0[e] = (f16)x[2][e]; oV1[e] = (f16)x[2][8 + e];
            oQ0[e] = (f16)(kk[e] * rn); oQ1[e] = (f16)(kk[8 + e] * rn);
        }
        const size_t o = (size_t)r * 1024 + c;
        *(f16x8*)(R + o) = oR0; *(f16x8*)(R + o + 8) = oR1; *(f16x8*)(K + o) = oK0; *(f16x8*)(K + o + 8) = oK1;
        *(f16x8*)(V + o) = oV0; *(f16x8*)(V + o + 8) = oV1; *(f16x8*)(KK + o) = oQ0; *(f16x8*)(KK + o + 8) = oQ1;
    }
}

__device__ __forceinline__ void phase_rwscan(const Params& P, int seg, float* lds) {
    const int tid = otid(), lane = tid & 63, wave = tid >> 6;
    unsigned char* ws = ows(P.ws);
    const f16* R = (const f16*)(ws + OFF_R); const f16* K = (const f16*)(ws + OFF_K); const f16* V = (const f16*)(ws + OFF_V); const f16* KK = (const f16*)(ws + OFF_KK);
    const f16* A = (const f16*)(ws + OFF_A); const f16* LD = (const f16*)(ws + OFF_LD); f16* Y = (f16*)(ws + OFF_Y);
    float* buf = lds;
    float* vbuf = lds + 2 * 5 * 2048;
    float* yp = vbuf + 2 * 512;
    constexpr int NCH = SEGT / 32;
    for (int item = blockIdx.x; item < 256; item += gridDim.x) {
        const int b = item >> 6, h = (item >> 2) & 15, rg = item & 3;
        const size_t rowbase = (size_t)b * SEGT;
        float* st = (float*)(ws + OFF_STATE) + ((size_t)item * 256 + (tid & 255)) * 4;
        f32x4 S = (f32x4){0.f, 0.f, 0.f, 0.f};
        if (wave < 4 && seg > 0) S = *(const f32x4*)st;
        const int ks = (lane & 15) * 4, rr = lane >> 4;
        auto load_chunk = [&](int c) {
            const int lt = tid - 256, p = c & 1, tt = lt >> 3, c8 = (lt & 7) * 8;
            const size_t o = (rowbase + c * 32 + tt) * 1024 + h * 64 + c8;
            float r8[8], k8[8], q8[8], a8[8], d8[8];
            ld8f(R + o, r8); ld8f(K + o, k8); ld8f(KK + o, q8); ld8f(A + o, a8); ld8f(LD + o, d8);
            float* bp = buf + p * 5 * 2048 + tt * 64 + c8;
#pragma unroll
            for (int e = 0; e < 8; ++e) { bp[e] = __expf(d8[e]); bp[2048 + e] = k8[e]; bp[2 * 2048 + e] = -q8[e]; bp[3 * 2048 + e] = q8[e] * a8[e]; bp[4 * 2048 + e] = r8[e]; }
            if (lt < 64) { const int t2 = lt >> 1, hf = lt & 1; float v8[8]; ld8f(V + (rowbase + c * 32 + t2) * 1024 + h * 64 + rg * 16 + hf * 8, v8);
#pragma unroll
                for (int e = 0; e < 8; ++e) vbuf[p * 512 + t2 * 16 + hf * 8 + e] = v8[e]; }
        };
        auto drain_chunk = [&](int c) {
            const int lt = tid - 256, p = c & 1;
#pragma unroll
            for (int i = 0; i < 2; ++i) {
                const int o = lt + i * 256, tok = o >> 4, ri = o & 15;
                const float* yy = yp + p * 8192 + tok * 256 + (ri >> 2) * 64 + (ri & 3) * 16;
                const f32x4 s0 = *(const f32x4*)yy, s1 = *(const f32x4*)(yy + 4), s2 = *(const f32x4*)(yy + 8), s3 = *(const f32x4*)(yy + 12);
                const float s = ((s0[0] + s0[1]) + (s0[2] + s0[3])) + ((s1[0] + s1[1]) + (s1[2] + s1[3])) + ((s2[0] + s2[1]) + (s2[2] + s2[3])) + ((s3[0] + s3[1]) + (s3[2] + s3[3]));
                Y[(rowbase + c * 32 + tok) * 1024 + h * 64 + rg * 16 + ri] = (f16)s;
            }
        };
        if (wave >= 4) load_chunk(0);
        __syncthreads();
        for (int c = 0; c < NCH; ++c) {
            if (wave < 4) {
                const int p = c & 1;
                const float* bp = buf + p * 5 * 2048 + ks; const float* vp = vbuf + p * 512 + wave * 4 + rr; float* yo = yp + p * 8192 + wave * 64 + lane;
#pragma unroll 4
                for (int t = 0; t < 32; ++t) {
                    const f32x4 w4 = *(const f32x4*)(bp + t * 64), k4 = *(const f32x4*)(bp + 2048 + t * 64), a4 = *(const f32x4*)(bp + 4096 + t * 64), b4 = *(const f32x4*)(bp + 6144 + t * 64), r4 = *(const f32x4*)(bp + 8192 + t * 64);
                    const float v = vp[t * 16];
                    float sa = (S[0] * a4[0] + S[1] * a4[1]) + (S[2] * a4[2] + S[3] * a4[3]);
                    sa = red16(sa);
                    S[0] = S[0] * w4[0] + (sa * b4[0] + v * k4[0]); S[1] = S[1] * w4[1] + (sa * b4[1] + v * k4[1]);
                    S[2] = S[2] * w4[2] + (sa * b4[2] + v * k4[2]); S[3] = S[3] * w4[3] + (sa * b4[3] + v * k4[3]);
                    yo[t * 256] = (S[0] * r4[0] + S[1] * r4[1]) + (S[2] * r4[2] + S[3] * r4[3]);
                }
            } else {
                if (c + 1 < NCH) load_chunk(c + 1);
                if (c > 0) drain_chunk(c - 1);
            }
            __syncthreads();
        }
        if (wave >= 4) drain_chunk(NCH - 1);
        if (wave < 4) *(f32x4*)st = S;
        __syncthreads();
    }
}

__device__ __forceinline__ float gelu_tanh(float x) { const float u = 0.7978845608028654f * (x + 0.044715f * x * x * x); const float t = 1.f - 2.f / (1.f + __expf(2.f * u)); return 0.5f * x * (1.f + t); }

__device__ __forceinline__ void phase_mix(const Params& P, int l, int seg, float* lds) {
    const int tid = otid(), lane = tid & 63, wave = tid >> 6, gw = blockIdx.x * 8 + wave, nw = gridDim.x * 8;
    unsigned char* ws = ows(P.ws);
    { const f16* LA = (const f16*)(ws + OFF_LOGA); const f16* U = (const f16*)(ws + OFF_U); const f16* XY = (const f16*)(ws + OFF_LRUXY); f16* YA = (f16*)(ws + OFF_YA); float* HC = (float*)(ws + OFF_HC);
      float* Ls = lds; float* Hs = lds + 512;
      for (int item = blockIdx.x; item < 160; item += gridDim.x) {
          const int b = item / 40, c = (item % 40) * 32 + (tid & 31), tc = tid >> 5;
          const size_t r0 = (size_t)b * SEGT + tc * 128;
          float L = 0.f, H = 0.f;
          for (int s = 0; s < 128; ++s) { const float la = (float)LA[(r0 + s) * LRUW + c], u = (float)U[(r0 + s) * LRUW + c]; H = __expf(la) * H + u; L += la; }
          Ls[tc * 32 + (tid & 31)] = L; Hs[tc * 32 + (tid & 31)] = H;
          __syncthreads();
          float hin = seg > 0 ? HC[b * LRUW + c] : 0.f;
          for (int j = 0; j < tc; ++j) hin = __expf(Ls[j * 32 + (tid & 31)]) * hin + Hs[j * 32 + (tid & 31)];
          __syncthreads();
          H = hin;
          for (int s = 0; s < 128; ++s) { const float la = (float)LA[(r0 + s) * LRUW + c], u = (float)U[(r0 + s) * LRUW + c]; H = __expf(la) * H + u;
              const float y = (float)XY[(r0 + s) * 2560 + 1280 + c]; YA[(r0 + s) * LRUW + c] = (f16)(H * gelu_tanh(y)); }
          if (tc == 15) HC[b * LRUW + c] = H;
          __syncthreads();
      } }
    { const f16* Y = (const f16*)(ws + OFF_Y); const f16* R = (const f16*)(ws + OFF_R); const f16* K = (const f16*)(ws + OFF_K); const f16* V = (const f16*)(ws + OFF_V); const f16* G = (const f16*)(ws + OFF_G); f16* YB = (f16*)(ws + OFF_YB);
      const float* rk = P.in[I_RK] + l * 1024; const float* lw = P.in[I_LNW] + l * 1024; const float* lb = P.in[I_LNB] + l * 1024;
      for (int r = gw; r < MS; r += nw) {
          const size_t o = (size_t)r * 1024 + lane * 16; const int c = lane * 16;
          float y[16], rv[16], kv[16], vv[16], gv[16], rkv[16], lwv[16], lbv[16];
          ld8f(Y + o, y); ld8f(Y + o + 8, y + 8); ld8f(R + o, rv); ld8f(R + o + 8, rv + 8); ld8f(K + o, kv); ld8f(K + o + 8, kv + 8); ld8f(V + o, vv); ld8f(V + o + 8, vv + 8); ld8f(G + o, gv); ld8f(G + o + 8, gv + 8);
          ld8g(rk + c, rkv); ld8g(rk + c + 8, rkv + 8); ld8g(lw + c, lwv); ld8g(lw + c + 8, lwv + 8); ld8g(lb + c, lbv); ld8g(lb + c + 8, lbv + 8);
          float s = 0.f, bo = 0.f;
#pragma unroll
          for (int e = 0; e < 16; ++e) { s += y[e]; bo += rv[e] * kv[e] * rkv[e]; }
          s += __shfl_xor(s, 1); s += __shfl_xor(s, 2); bo += __shfl_xor(bo, 1); bo += __shfl_xor(bo, 2);
          const float mean = s * (1.f / 64.f); float q = 0.f;
#pragma unroll
          for (int e = 0; e < 16; ++e) { const float d = y[e] - mean; q += d * d; }
          q += __shfl_xor(q, 1); q += __shfl_xor(q, 2);
          const float rs = rsqrtf(q * (1.f / 64.f) + 64e-5f);
          f16x8 o0, o1;
#pragma unroll
          for (int e = 0; e < 16; ++e) { const float v = ((y[e] - mean) * rs * lwv[e] + lbv[e] + bo * vv[e]) * gv[e]; if (e < 8) o0[e] = (f16)v; else o1[e - 8] = (f16)v; }
          *(f16x8*)(YB + o) = o0; *(f16x8*)(YB + o + 8) = o1;
      } }
    { f16* Q = (f16*)(ws + OFF_Q); const f16* KN = (const f16*)(ws + OFF_KN); const f16* VT = (const f16*)(ws + OFF_VT);
      const float* sinks = P.in[I_SINK] + l * 16;
      const int qi = lane & 15, quad = lane >> 4;
      for (int u = gw; u < (MS / 16) * 16; u += nw) {
          const int tile = u >> 4, h = u & 15, kvh = h >> 2, r0 = tile * 16, b = r0 >> 11, pos0 = seg * SEGT + (r0 & 2047);
          const f16* qp = Q + (size_t)(r0 + qi) * 1024 + h * 64 + quad * 8;
          const f16x8 qf0 = *(const f16x8*)qp, qf1 = *(const f16x8*)(qp + 32);
          f32x4 sc[10];
          const int qpos = pos0 + qi;
#pragma unroll
          for (int tt = 0; tt < 10; ++tt) {
              const int ks0 = pos0 - 144 + 16 * tt;
              if (tt == 0 || ks0 < 0) { sc[tt] = (f32x4){-1e30f, -1e30f, -1e30f, -1e30f}; continue; }
              const f16* kp = KN + ((size_t)b * SEQ + ks0 + qi) * 256 + kvh * 64 + quad * 8;
              const f16x8 kf0 = *(const f16x8*)kp, kf1 = *(const f16x8*)(kp + 32);
              f32x4 s = (f32x4){0.f, 0.f, 0.f, 0.f};
              s = __builtin_amdgcn_mfma_f32_16x16x32_f16(kf0, qf0, s, 0, 0, 0);
              s = __builtin_amdgcn_mfma_f32_16x16x32_f16(kf1, qf1, s, 0, 0, 0);
#pragma unroll
              for (int j = 0; j < 4; ++j) { const int kpos = ks0 + quad * 4 + j; const bool ok = (kpos <= qpos) && (qpos - kpos < 128); s[j] = ok ? s[j] : -1e30f; }
              sc[tt] = s;
          }
          float m = -1e30f;
#pragma unroll
          for (int tt = 0; tt < 10; ++tt) m = fmaxf(m, fmaxf(fmaxf(sc[tt][0], sc[tt][1]), fmaxf(sc[tt][2], sc[tt][3])));
          m = fmaxf(m, __shfl_xor(m, 16)); m = fmaxf(m, __shfl_xor(m, 32));
          const float sink = sinks[h]; m = fmaxf(m, sink);
          float sum = 0.f;
#pragma unroll
          for (int tt = 0; tt < 10; ++tt)
#pragma unroll
              for (int j = 0; j < 4; ++j) { const float e = __expf(sc[tt][j] - m); sc[tt][j] = e; sum += e; }
          sum += __shfl_xor(sum, 16); sum += __shfl_xor(sum, 32);
          const float inv = 1.f / (sum + __expf(sink - m));
          f32x4 o[4];
#pragma unroll
          for (int dt = 0; dt < 4; ++dt) o[dt] = (f32x4){0.f, 0.f, 0.f, 0.f};
#pragma unroll
          for (int gI = 0; gI < 5; ++gI) {
              const int ksA = pos0 - 144 + 32 * gI, ksB = ksA + 16;
              const bool okA = (gI > 0) && ksA >= 0, okB = ksB >= 0;
              if (!okB) continue;
              f16x8 pf;
#pragma unroll
              for (int j = 0; j < 4; ++j) { pf[j] = (f16)(sc[2 * gI][j] * inv); pf[4 + j] = (f16)(sc[2 * gI + 1][j] * inv); }
#pragma unroll
              for (int dt = 0; dt < 4; ++dt) {
                  const f16* vp = VT + ((size_t)((b * 4 + kvh) * 64 + dt * 16 + qi)) * SEQ + quad * 4;
                  f16x4 va = (f16x4){(f16)0.f, (f16)0.f, (f16)0.f, (f16)0.f};
                  if (okA) va = *(const f16x4*)(vp + ksA);
                  const f16x4 vb = *(const f16x4*)(vp + ksB);
                  f16x8 vf; vf[0] = va[0]; vf[1] = va[1]; vf[2] = va[2]; vf[3] = va[3]; vf[4] = vb[0]; vf[5] = vb[1]; vf[6] = vb[2]; vf[7] = vb[3];
                  o[dt] = __builtin_amdgcn_mfma_f32_16x16x32_f16(vf, pf, o[dt], 0, 0, 0);
              }
          }
          f16* op = Q + (size_t)(r0 + qi) * 1024 + h * 64 + quad * 4;
#pragma unroll
          for (int dt = 0; dt < 4; ++dt) { f16x4 ov; ov[0] = (f16)o[dt][0]; ov[1] = (f16)o[dt][1]; ov[2] = (f16)o[dt][2]; ov[3] = (f16)o[dt][3]; *(f16x4*)(op + dt * 16) = ov; }
      } }
}

constexpr int PH_PER_SEG = 12, PH_PER_LAYER = 1 + NSEG * PH_PER_SEG, N_PHASES = 1 + 2 * PH_PER_LAYER;

struct Job { const f16* A; const f16* Bt; int lda, ldb, nt, N, cshift, kind, lru; };
__device__ __forceinline__ int gemm_jobs(int sub, int l) { return sub == 1 ? 1 : sub == 3 ? (l == 1 ? 5 : 4) : sub == 7 ? 3 : (sub == 8 || sub == 10 || sub == 11) ? 1 : 0; }
__device__ __forceinline__ Job make_job(unsigned char* ws, int sub, int j, int l) {
    const f16* W = (const f16*)(ws + OFF_W);
    switch (sub) {
    case 1: return Job{(const f16*)(ws + OFF_H), W + W_IN, 1024, 1024, 16, l == 0 ? 10752 : NIN, 0, 0, 0};
    case 3:
        switch (j) {
        case 0: return Job{(const f16*)(ws + OFF_XA), W + W_LG, 1280, 1280, 4, 2560, 0, 1, 1};
        case 1: return Job{(const f16*)(ws + OFF_ALORA), W + W_W2, 512, 128, 2, 1024, 64, 2, 0};
        case 2: return Job{(const f16*)(ws + OFF_ALORA) + 128, W + W_A2, 512, 128, 2, 1024, 192, 3, 0};
        case 3: return Job{(const f16*)(ws + OFF_ALORA) + 256, W + W_G2, 512, 256, 4, 1024, 128, 4, 0};
        default: return Job{(const f16*)(ws + OFF_V1O), W + W_V2, 256, 128, 2, 1024, 0, 5, 0};
        }
    case 7:
        switch (j) {
        case 0: return Job{(const f16*)(ws + OFF_YA), W + W_LO, 1280, 1280, 20, 1024, 0, 6, 0};
        case 1: return Job{(const f16*)(ws + OFF_YB), W + W_RO, 1024, 1024, 16, 1024, 0, 7, 0};
        default: return Job{(const f16*)(ws + OFF_Q), W + W_AO, 1024, 1024, 16, 1024, 0, 8, 0};
        }
    case 8: return Job{(const f16*)(ws + OFF_MIXED), W + W_OUT, 1024, 1024, 16, 1024, 0, 9, 0};
    case 10: return Job{(const f16*)(ws + OFF_H), W + W_FI, 1024, 1024, 16, 5632, 0, 10, 0};
    default: return Job{(const f16*)(ws + OFF_FFH), W + W_FO, DFF, DFF, 44, 1024, 0, 11, 0};
    }
}

__global__ void __launch_bounds__(NTHR) fwd_kernel(Params P) {
    extern __shared__ __attribute__((aligned(16))) unsigned char smem[];
    LAS unsigned char* lds = (LAS unsigned char*)smem;
    float* ldsf = (float*)smem;
    unsigned char* ws = ows(P.ws);
    const int G = gridDim.x, cid = blockIdx.x;
    for (int ph = P.ph_lo; ph < P.ph_hi; ++ph) {
        if (ph == 0) { if (PHON(12)) phase_mod(P, ldsf); }
        else {
            const int p = ph - 1, l = p / PH_PER_LAYER, q = p % PH_PER_LAYER;
            const float* xin = l == 0 ? P.in[I_X] : P.out;
            if (q == 0) { if (PHON(13)) phase_prep(P, l, ldsf); }
            else {
                const int seg = (q - 1) / PH_PER_SEG, sub = (q - 1) % PH_PER_SEG;
                const int nj = gemm_jobs(sub, l);
                if (nj > 0) {
                    if (PHON(1)) for (int j = 0; j < nj; ++j) {
                        const Job jb = make_job(ws, sub, j, l);
                        pg8::Gemm g{jb.A, jb.Bt, jb.lda, jb.ldb, jb.nt}; pg8::StaticOrder S; S.init(MS, jb.N, G, (cid + jb.cshift) % G, jb.lru);
                        EpiDispatch ED{jb.kind, P, l, seg};
                        pg8::gemm_phase(lds, g, S, ED);
                    }
                } else {
                    switch (sub) {
                    case 0: if (PHON(0)) phase_norm(P, xin, l, seg, 0); break;
                    case 2: if (PHON(2)) phase_elem(P, l, seg); break;
                    case 4: if (PHON(4)) phase_rwprep(P, l, seg); break;
                    case 5: if (PHON(5)) phase_rwscan(P, seg, ldsf); break;
                    case 6: if (PHON(6)) phase_mix(P, l, seg, ldsf); break;
                    default: if (PHON(9)) phase_norm(P, P.out, l, seg, 1); break;
                    }
                }
            }
        }
        if (P.coop && ph + 1 < P.ph_hi) cg::this_grid().sync();
    }
}

extern "C" void kernel_launch(void* const* d_in, const int* in_sizes, int n_in, void* d_out, int out_size, void* d_ws, size_t ws_size, hipStream_t stream) {
    static int grid = 0;
    if (grid == 0) {
        int dev = 0, cus = 0, per_cu = 0;
        hipGetDevice(&dev); hipDeviceGetAttribute(&cus, hipDeviceAttributeMultiprocessorCount, dev);
        hipFuncSetAttribute((const void*)fwd_kernel, hipFuncAttributeMaxDynamicSharedMemorySize, LDS_BYTES);
        hipOccupancyMaxActiveBlocksPerMultiprocessor(&per_cu, (const void*)fwd_kernel, NTHR, LDS_BYTES);
        if (per_cu < 1) per_cu = 1;
        grid = cus * per_cu;
        if (n_in != 35 || ws_size < WS_END) { fprintf(stderr, "kernel_launch: unexpected n_in %d / ws_size %zu\n", n_in, ws_size); grid = -1; }
    }
    if (grid < 0) return;
    Params p{};
    for (int i = 0; i < 35; ++i) p.in[i] = (const float*)d_in[i];
    p.out = (float*)d_out; p.ws = (unsigned char*)d_ws;
#if COOP
    p.ph_lo = 0; p.ph_hi = N_PHASES; p.coop = 1;
    void* args[] = {&p};
    hipError_t e = hipLaunchCooperativeKernel((const void*)fwd_kernel, dim3(grid), dim3(NTHR), args, LDS_BYTES, stream);
    if (e != hipSuccess) fprintf(stderr, "cooperative launch failed: %s (grid %d)\n", hipGetErrorString(e), grid);
#else
    for (int ph = 0; ph < N_PHASES; ++ph) {
        p.ph_lo = ph; p.ph_hi = ph + 1; p.coop = 0;
        hipLaunchKernelGGL(fwd_kernel, dim3(grid), dim3(NTHR), LDS_BYTES, stream, p);
    }
#endif
}
```

```cpp
#include <hip/hip_runtime.h>
#include <hip/hip_cooperative_groups.h>
#include <cstdio>
#include <cstdint>
namespace cg = cooperative_groups;

#ifndef COOP
#define COOP 1
#endif
#ifndef PHMASK
#define PHMASK 0xFFFF
#endif
#define PHON(i) ((PHMASK >> (i)) & 1)
#ifndef TSEL
#define TSEL 0xFF
#endif
#define TS(i) ((TSEL >> (i)) & 1)
#ifndef EPIMASK
#define EPIMASK 0xFFFF
#endif
#define EPON(i) ((EPIMASK >> (i)) & 1)

#define LAS __attribute__((address_space(3)))
typedef _Float16 f16;
typedef _Float16 f16x8 __attribute__((ext_vector_type(8)));
typedef _Float16 f16x4 __attribute__((ext_vector_type(4)));
typedef float f32x4 __attribute__((ext_vector_type(4)));

constexpr int NB = 4, SEQ = 8192, DM = 1024, TT = NB * SEQ;
constexpr int SEGT = 2048, NSEG = SEQ / SEGT, MS = NB * SEGT;
constexpr int LRUW = 1280, DFF = 2816, INC = 10528, RWC = 3360;
constexpr int NIN = 11008;
constexpr int NTHR = 512;
constexpr int LDS_BYTES = 155648;

constexpr size_t MiB = 1u << 20;
constexpr size_t OFF_MOD = 0;
constexpr size_t OFF_CONVC = 256 * 1024;
constexpr size_t OFF_RKVC = 384 * 1024;
constexpr size_t OFF_LORAC = 512 * 1024;
constexpr size_t OFF_HC = 640 * 1024;
constexpr size_t OFF_SP = 704 * 1024;
constexpr size_t OFF_STATE = 1 * MiB;
constexpr size_t OFF_W = 2 * MiB;
constexpr size_t OFF_VFIRST = 66 * MiB;
constexpr size_t OFF_KN = 130 * MiB;
constexpr size_t OFF_VT = 146 * MiB;
constexpr size_t OFF_H = 162 * MiB;
constexpr size_t OFF_LRUXY = 178 * MiB;
constexpr size_t OFF_RKV = 218 * MiB;
constexpr size_t OFF_LORAR = 266 * MiB;
constexpr size_t OFF_ALORA = 274 * MiB;
constexpr size_t OFF_Q = 282 * MiB;
constexpr size_t OFF_KVRAW = 298 * MiB;
constexpr size_t OFF_GATES = 306 * MiB;
constexpr size_t OFF_V1O = 354 * MiB;
constexpr size_t OFF_XA = 358 * MiB;
constexpr size_t OFF_LOGA = 378 * MiB;
constexpr size_t OFF_U = 398 * MiB;
constexpr size_t OFF_LD = 418 * MiB;
constexpr size_t OFF_A = 434 * MiB;
constexpr size_t OFF_G = 450 * MiB;
constexpr size_t OFF_VMIX = 466 * MiB;
constexpr size_t OFF_KK = 482 * MiB;
constexpr size_t OFF_R = OFF_H, OFF_K = OFF_LORAR, OFF_V = OFF_XA, OFF_YA = OFF_RKV, OFF_Y = 238 * MiB, OFF_FFH = OFF_LRUXY;
constexpr size_t OFF_MERGED = OFF_LD, OFF_MIXED = OFF_G, OFF_YB = OFF_VMIX;
constexpr size_t WS_END = 498 * MiB;
constexpr size_t W_IN = 0, W_LG = W_IN + (size_t)NIN * 1024, W_LO = W_LG + 2560 * 1280, W_RO = W_LO + 1024 * 1280, W_AO = W_RO + 1024 * 1024, W_OUT = W_AO + 1024 * 1024,
                 W_FI = W_OUT + 1024 * 1024, W_FO = W_FI + 5632 * 1024, W_W2 = W_FO + 1024 * 2816, W_A2 = W_W2 + 1024 * 128, W_G2 = W_A2 + 1024 * 128, W_V2 = W_G2 + 1024 * 256, W_TOT = W_V2 + 1024 * 128;
static_assert(W_TOT * 2 <= 64 * MiB, "weights");

struct Params { const float* in[35]; float* out; unsigned char* ws; int ph_lo, ph_hi; int coop; int pad; };
enum { I_X = 0, I_C, I_WADA, I_BADA, I_WIN, I_CONVW, I_CONVB, I_LRUWA, I_LRUBA, I_LRUWX, I_LRUBX, I_LAM, I_WLRUO, I_MU, I_W0, I_W2, I_A0, I_A2, I_G2, I_KK, I_KA, I_RK, I_LNW, I_LNB,
       I_V0, I_V1, I_V2, I_WRWO, I_QG, I_KG, I_SINK, I_WATTO, I_WOUT, I_WFI, I_WFO };

__device__ __forceinline__ int otid() { int t = threadIdx.x; asm volatile("" : "+v"(t)); return t; }
__device__ __forceinline__ unsigned char* ows(unsigned char* p) { asm volatile("" : "+s"(p)); return p; }
__device__ __forceinline__ float sigm(float x) { return 1.f / (1.f + __expf(-x)); }
__device__ __forceinline__ float wave_sum(float v) {
#pragma unroll
    for (int o = 1; o < 64; o <<= 1) v += __shfl_xor(v, o);
    return v;
}
template <int CTRL> __device__ __forceinline__ float dppf(float x) { return __builtin_bit_cast(float, __builtin_amdgcn_update_dpp(0, __builtin_bit_cast(int, x), CTRL, 0xf, 0xf, false)); }
__device__ __forceinline__ float red16(float x) { x += dppf<0x128>(x); x += dppf<0x124>(x); x += dppf<0x122>(x); x += dppf<0x121>(x); return x; }
__device__ __forceinline__ int grow(int r, int seg) { return (r >> 11) * SEQ + seg * SEGT + (r & (SEGT - 1)); }

namespace pg8 {
constexpr int BM = 256, BK = 64, HALF = 128, HTB = HALF * BK * 2, STAGE_BYTES = 8 * HTB, NXCD = 8, WGM = 8;
__host__ __device__ __forceinline__ int lds_byte(int r, int c) { const int st = (r >> 4) * 2 + (c >> 5), rr = r & 15, cc = c & 31, ob = rr * 64 + cc * 2; return st * 1024 + (ob ^ (((ob >> 9) & 1) << 5)); }
__host__ __device__ __forceinline__ void stage_rc(int b, int& R, int& C) { const int st = b / 1024, sb = b % 1024, swz = sb ^ (((sb >> 9) & 1) << 5); R = (st >> 1) * 16 + swz / 64; C = (st & 1) * 32 + (swz % 64) / 2; }
__host__ __device__ __forceinline__ int perm32(int rho) { const int n = rho >> 4, i = rho & 15; return 8 * (i >> 2) + 4 * n + (i & 3); }
struct Unit { int pm, pn, koff; };
struct Gemm { const f16* A; const f16* Bt; int lda, ldb, nt; };
struct StaticOrder {
    int nM, nN, nwg, G, c, lru;
    __device__ void init(int M, int N, int G_, int c_, int lru_) { nM = M / BM; nN = N / BM; nwg = nM * nN; G = G_; c = c_; lru = lru_; }
    __device__ bool next(int i, Unit& u) const {
        const long L = (long)i * G + c; if (L >= nwg) return false;
        int wgid = (int)L; { const int q = nwg / NXCD, r = nwg % NXCD, xcd = wgid % NXCD, off = wgid / NXCD; wgid = (xcd < r ? xcd * (q + 1) : r * (q + 1) + (xcd - r) * q) + off; }
        const int nig = WGM * nN, gid = wgid / nig, fm = gid * WGM, gsz = (nM - fm) < WGM ? (nM - fm) : WGM;
        u.pm = fm + ((wgid % nig) % gsz); u.pn = (wgid % nig) / gsz; u.koff = 0;
        if (lru) { const int j = u.pn; u.koff = j == 0 ? 0 : j == 1 ? 64 : j == 2 ? 192 : j == 3 ? 320 : j == 4 ? 448 : j == 5 ? 640 : j == 6 ? 704 : j == 7 ? 832 : j == 8 ? 960 : 1024; }
        return true;
    }
};
template <class EpiD>
__device__ __forceinline__ void gemm_phase(LAS unsigned char* lds, const Gemm g, const StaticOrder& S, const EpiD& ED) {
    const int tid = otid(), wid = __builtin_amdgcn_readfirstlane(tid >> 6), lane = tid & 63, wr = wid >> 2, wc = wid & 3, fr = lane & 15, fq = lane >> 4;
    const int nt = g.nt;
    unsigned voffA[2], voffB[2];
#pragma unroll
    for (int i = 0; i < 2; ++i) { int R, C; stage_rc(tid * 16 + i * 8192, R, C); const int Rb = (R & ~31) + perm32(R & 31);
        voffA[i] = (unsigned)(R * g.lda + C) * 2u; voffB[i] = (unsigned)(Rb * g.ldb + C) * 2u; }
    const size_t kstep = (size_t)(BK * 2);
    const size_t hstepA = (size_t)HALF * g.lda * 2, hstepB = (size_t)HALF * g.ldb * 2;
    const unsigned ldsw = (unsigned)wid * 1024u;
    const int aoff = lds_byte(wr * 64 + fr, fq * 8), boff = lds_byte(wc * 32 + fr, fq * 8);
#define PG8_SA(b, h) (((b) * 2 + (h)) * HTB)
#define PG8_SB(b, h) ((4 + (b) * 2 + (h)) * HTB)
#define PG8_STAGE(bufoff, gbase, voff) do { _Pragma("unroll") for (int _i = 0; _i < 2; ++_i) \
        __builtin_amdgcn_global_load_lds((const unsigned*)((const char*)(gbase) + (voff)[_i]), (LAS unsigned*)(lds + (bufoff) + ldsw + _i * 8192), 16, 0, 0); } while (0)
#define PG8_LDA(dst, b, h) do { _Pragma("unroll") for (int m = 0; m < 4; ++m) _Pragma("unroll") for (int k = 0; k < 2; ++k) dst[m][k] = *(const LAS f16x8*)(lds + PG8_SA(b, h) + aoff + m * 2048 + k * 1024); } while (0)
#define PG8_LDB(dst, b, h) do { _Pragma("unroll") for (int n = 0; n < 2; ++n) _Pragma("unroll") for (int k = 0; k < 2; ++k) dst[n][k] = *(const LAS f16x8*)(lds + PG8_SB(b, h) + boff + n * 2048 + k * 1024); } while (0)
#define PG8_MMA(ai, bj, At, Bt) do { __builtin_amdgcn_s_setprio(1); _Pragma("unroll") for (int m = 0; m < 4; ++m) _Pragma("unroll") for (int n = 0; n < 2; ++n) _Pragma("unroll") for (int k = 0; k < 2; ++k) \
        acc[ai][bj][m][n] = __builtin_amdgcn_mfma_f32_16x16x32_f16(Bt[n][k], At[m][k], acc[ai][bj][m][n], 0, 0, 0); __builtin_amdgcn_s_setprio(0); } while (0)
#define PG8_WAIT_V(n) asm volatile("s_waitcnt vmcnt(" #n ")" ::: "memory")
#define PG8_WAIT_L(n) asm volatile("s_waitcnt lgkmcnt(" #n ")" ::: "memory")
#define PG8_BAR __builtin_amdgcn_s_barrier()
#define PG8_SCHED __builtin_amdgcn_sched_barrier(0)
    Unit cur, nxt; int ui = 0;
    if (!S.next(0, cur)) return;
    f32x4 acc[2][2][4][2];
#pragma unroll
    for (int a = 0; a < 2; ++a)
#pragma unroll
        for (int b = 0; b < 2; ++b)
#pragma unroll
            for (int m = 0; m < 4; ++m)
#pragma unroll
                for (int n = 0; n < 2; ++n) acc[a][b][m][n] = (f32x4){0.f, 0.f, 0.f, 0.f};
    f16x8 At[4][2], B0[2][2], B1[2][2];
    const char* cA = (const char*)g.A + (size_t)cur.pm * 2 * hstepA + (size_t)cur.koff * 2; const char* cB = (const char*)g.Bt + (size_t)cur.pn * 2 * hstepB + (size_t)cur.koff * 2;
    PG8_STAGE(PG8_SB(0, 0), cB, voffB); PG8_STAGE(PG8_SB(0, 1), cB + hstepB, voffB); PG8_STAGE(PG8_SA(0, 0), cA, voffA); PG8_STAGE(PG8_SA(0, 1), cA + hstepA, voffA);
    if (wr == 1) PG8_BAR;
    PG8_WAIT_V(2); PG8_BAR;
    PG8_STAGE(PG8_SB(1, 0), cB + kstep, voffB); PG8_STAGE(PG8_SA(1, 0), cA + kstep, voffA); PG8_STAGE(PG8_SB(1, 1), cB + hstepB + kstep, voffB);
    PG8_WAIT_V(6); PG8_BAR;
    for (;;) {
        const bool has_next = S.next(ui + 1, nxt);
        const char* nA = has_next ? (const char*)g.A + (size_t)nxt.pm * 2 * hstepA + (size_t)nxt.koff * 2 : cA; const char* nB = has_next ? (const char*)g.Bt + (size_t)nxt.pn * 2 * hstepB + (size_t)nxt.koff * 2 : cB;
        for (int t = 0; t < nt; t += 2) {
            const bool last = (t == nt - 2);
            const char* a1 = cA + (size_t)(t + 1) * kstep;
            const char* a2 = last ? nA : cA + (size_t)(t + 2) * kstep; const char* b2 = last ? nB : cB + (size_t)(t + 2) * kstep;
            const char* a3 = a2 + kstep; const char* b3 = b2 + kstep;
            PG8_LDB(B0, 0, 0); PG8_LDB(B1, 0, 1); PG8_SCHED; PG8_LDA(At, 0, 0); PG8_STAGE(PG8_SA(1, 1), a1 + hstepA, voffA);
            PG8_WAIT_V(8); PG8_WAIT_L(0); PG8_BAR; PG8_MMA(0, 0, At, B0); PG8_MMA(0, 1, At, B1); PG8_BAR; PG8_SCHED;
            PG8_LDA(At, 0, 1); PG8_STAGE(PG8_SB(0, 0), b2, voffB); PG8_STAGE(PG8_SB(0, 1), b2 + hstepB, voffB); PG8_STAGE(PG8_SA(0, 0), a2, voffA);
            PG8_WAIT_V(8); PG8_WAIT_L(0); PG8_BAR; PG8_MMA(1, 0, At, B0); PG8_MMA(1, 1, At, B1); PG8_BAR; PG8_SCHED;
            PG8_LDB(B0, 1, 0); PG8_LDB(B1, 1, 1); PG8_SCHED; PG8_LDA(At, 1, 0); PG8_STAGE(PG8_SA(0, 1), a2 + hstepA, voffA);
            PG8_WAIT_V(8); PG8_WAIT_L(0); PG8_BAR; PG8_MMA(0, 0, At, B0); PG8_MMA(0, 1, At, B1); PG8_BAR; PG8_SCHED;
            PG8_LDA(At, 1, 1); PG8_STAGE(PG8_SB(1, 0), b3, voffB); PG8_STAGE(PG8_SB(1, 1), b3 + hstepB, voffB); PG8_STAGE(PG8_SA(1, 0), a3, voffA);
            PG8_WAIT_V(8); PG8_WAIT_L(0); PG8_BAR; PG8_MMA(1, 0, At, B0); PG8_MMA(1, 1, At, B1); PG8_BAR; PG8_SCHED;
        }
        if (wr == 0) PG8_BAR;
        ED(acc, cur, wr, wc, fr, fq);
        if (!has_next) break;
#pragma unroll
        for (int a = 0; a < 2; ++a)
#pragma unroll
            for (int b = 0; b < 2; ++b)
#pragma unroll
                for (int m = 0; m < 4; ++m)
#pragma unroll
                    for (int n = 0; n < 2; ++n) acc[a][b][m][n] = (f32x4){0.f, 0.f, 0.f, 0.f};
        cur = nxt; cA = nA; cB = nB; ++ui;
        if (wr == 1) PG8_BAR;
    }
    PG8_WAIT_V(0);
    PG8_BAR;
#undef PG8_SA
#undef PG8_SB
#undef PG8_STAGE
#undef PG8_LDA
#undef PG8_LDB
#undef PG8_MMA
#undef PG8_WAIT_V
#undef PG8_WAIT_L
#undef PG8_BAR
#undef PG8_SCHED
}
}

__device__ __forceinline__ void st8(f16* p, const f32x4& a, const f32x4& b) {
    f16x8 v; v[0] = (f16)a[0]; v[1] = (f16)a[1]; v[2] = (f16)a[2]; v[3] = (f16)a[3]; v[4] = (f16)b[0]; v[5] = (f16)b[1]; v[6] = (f16)b[2]; v[7] = (f16)b[3];
    *(f16x8*)p = v;
}
__device__ __forceinline__ void ld8f(const f16* p, float* o) { const f16x8 v = *(const f16x8*)p;
#pragma unroll
    for (int i = 0; i < 8; ++i) o[i] = (float)v[i]; }
__device__ __forceinline__ void ld8g(const float* p, float* o) { const f32x4 a = *(const f32x4*)p, b = *(const f32x4*)(p + 4); o[0] = a[0]; o[1] = a[1]; o[2] = a[2]; o[3] = a[3]; o[4] = b[0]; o[5] = b[1]; o[6] = b[2]; o[7] = b[3]; }

struct EpiProj {
    unsigned char* ws;
    __device__ __forceinline__ void operator()(int row, int pn, int cin, const f32x4& a0, const f32x4& a1, const f32x4& b0, const f32x4& b1) const {
        size_t off; int ld, ct;
        if (pn < 10) { off = OFF_LRUXY; ld = 2560; ct = pn; } else if (pn < 22) { off = OFF_RKV; ld = 3072; ct = pn - 10; } else if (pn < 24) { off = OFF_LORAR; ld = 512; ct = pn - 22; }
        else if (pn < 28) { off = OFF_Q; ld = 1024; ct = pn - 24; } else if (pn < 30) { off = OFF_KVRAW; ld = 512; ct = pn - 28; } else if (pn < 42) { off = OFF_GATES; ld = 3072; ct = pn - 30; }
        else { off = OFF_V1O; ld = 256; ct = 0; }
        f16* p = (f16*)(ws + off) + (size_t)row * ld + ct * 256 + cin;
        st8(p, a0, a1); st8(p + 128, b0, b1);
    }
};
struct EpiLruGate {
    const f16* xa; f16* loga; f16* u; const float* ba; const float* bx; const float* lam;
    __device__ __forceinline__ void operator()(int row, int pn, int cin, const f32x4& a0, const f32x4& a1, const f32x4& b0, const f32x4& b1) const {
        const int c0 = pn * 128 + cin; float xv[8], bav[8], bxv[8], lv[8];
        ld8f(xa + (size_t)row * LRUW + c0, xv); ld8g(ba + c0, bav); ld8g(bx + c0, bxv); ld8g(lam + c0, lv);
        f16x8 ol, ou;
#pragma unroll
        for (int e = 0; e < 8; ++e) {
            const float pa = (e < 4 ? a0[e & 3] : a1[e & 3]) + bav[e], px = (e < 4 ? b0[e & 3] : b1[e & 3]) + bxv[e];
            const float la = -8.f * sigm(pa) * lv[e];
            const float z = 2.f * la;
            const float em = z > -0.5f ? -z * (1.f + z * (0.5f + z * (0.16666667f + z * (0.041666668f + z * 0.0083333338f)))) : 1.f - __expf(z);
            const float mult = sqrtf(fmaxf(em, 0.f));
            ol[e] = (f16)la; ou[e] = (f16)(xv[e] * sigm(px) * mult);
        }
        *(f16x8*)(loga + (size_t)row * LRUW + c0) = ol; *(f16x8*)(u + (size_t)row * LRUW + c0) = ou;
    }
};
template <int MODE> struct EpiLora {
    f16* O; const float* bias;
    __device__ __forceinline__ void operator()(int row, int pn, int cin, const f32x4& a0, const f32x4& a1, const f32x4& b0, const f32x4& b1) const {
#pragma unroll
        for (int bj = 0; bj < 2; ++bj) {
            const int c0 = pn * 256 + bj * 128 + cin; float bv[8];
            if (MODE != 2) ld8g(bias + c0, bv);
            f16x8 o;
#pragma unroll
            for (int e = 0; e < 8; ++e) {
                const float v = bj == 0 ? (e < 4 ? a0[e & 3] : a1[e & 3]) : (e < 4 ? b0[e & 3] : b1[e & 3]);
                float r;
                if (MODE == 0) { const float z = bv[e] + v; const float sp = (z > 15.f) ? __expf(-z) : __logf(1.f + __expf(-z)); const float w = -sp - 0.5f; r = -__expf(w); }
                else if (MODE == 1) r = sigm(bv[e] + v);
                else r = v;
                o[e] = (f16)r;
            }
            *(f16x8*)(O + (size_t)row * 1024 + c0) = o;
        }
    }
};
template <int BR> struct EpiMerge {
    const f16* gates; float* merged; f16* mixed;
    __device__ __forceinline__ void operator()(int row, int pn, int cin, const f32x4& a0, const f32x4& a1, const f32x4& b0, const f32x4& b1) const {
#pragma unroll
        for (int bj = 0; bj < 2; ++bj) {
            const int c0 = pn * 256 + bj * 128 + cin; float gv[8], mv[8];
            ld8f(gates + (size_t)row * 3072 + BR * 1024 + c0, gv);
            float* mp = merged + (size_t)row * 1024 + c0;
            if (BR > 0) ld8g(mp, mv);
            float o[8];
#pragma unroll
            for (int e = 0; e < 8; ++e) {
                const float v = bj == 0 ? (e < 4 ? a0[e & 3] : a1[e & 3]) : (e < 4 ? b0[e & 3] : b1[e & 3]);
                o[e] = (BR > 0 ? mv[e] : 0.f) + sigm(gv[e]) * v;
            }
            if (BR < 2) { *(f32x4*)mp = (f32x4){o[0], o[1], o[2], o[3]}; *(f32x4*)(mp + 4) = (f32x4){o[4], o[5], o[6], o[7]}; }
            else { f16x8 h;
#pragma unroll
                for (int e = 0; e < 8; ++e) h[e] = (f16)o[e];
                *(f16x8*)(mixed + (size_t)row * 1024 + c0) = h; }
        }
    }
};
struct EpiResid {
    const float* xin; float* out; const float* gate  ; int seg;
    __device__ __forceinline__ void operator()(int row, int pn, int cin, const f32x4& a0, const f32x4& a1, const f32x4& b0, const f32x4& b1) const {
        const size_t g = (size_t)grow(row, seg); const int b = row >> 11;
#pragma unroll
        for (int bj = 0; bj < 2; ++bj) {
            const int c0 = pn * 256 + bj * 128 + cin; float xv[8], gv[8];
            ld8g(xin + g * 1024 + c0, xv); ld8g(gate + b * 6144 + c0, gv);
            float o[8];
#pragma unroll
            for (int e = 0; e < 8; ++e) { const float v = bj == 0 ? (e < 4 ? a0[e & 3] : a1[e & 3]) : (e < 4 ? b0[e & 3] : b1[e & 3]); o[e] = xv[e] + gv[e] * v; }
            float* op = out + g * 1024 + c0;
            *(f32x4*)op = (f32x4){o[0], o[1], o[2], o[3]}; *(f32x4*)(op + 4) = (f32x4){o[4], o[5], o[6], o[7]};
        }
    }
};
struct EpiSwiglu {
    f16* ffh;
    __device__ __forceinline__ void operator()(int row, int pn, int cin, const f32x4& a0, const f32x4& a1, const f32x4& b0, const f32x4& b1) const {
        f16x8 o;
#pragma unroll
        for (int e = 0; e < 8; ++e) { const float gt = e < 4 ? a0[e & 3] : a1[e & 3], up = e < 4 ? b0[e & 3] : b1[e & 3]; o[e] = (f16)(gt * sigm(gt) * up); }
        *(f16x8*)(ffh + (size_t)row * DFF + pn * 128 + cin) = o;
    }
};
struct EpiDispatch {
    int kind; const Params& P; int l, seg;
    template <class E> __device__ __forceinline__ void run(const E& e, const f32x4 (&acc)[2][2][4][2], const pg8::Unit& u, int wr, int wc, int fr, int fq) const {
#pragma unroll
        for (int ai = 0; ai < 2; ++ai)
#pragma unroll
            for (int m = 0; m < 4; ++m) {
                const int row = u.pm * 256 + ai * 128 + wr * 64 + m * 16 + fr;
                __builtin_amdgcn_sched_barrier(0);
                e(row, u.pn, wc * 32 + 8 * fq, acc[ai][0][m][0], acc[ai][0][m][1], acc[ai][1][m][0], acc[ai][1][m][1]);
            }
    }
    __device__ __forceinline__ void operator()(const f32x4 (&acc)[2][2][4][2], const pg8::Unit& u, int wr, int wc, int fr, int fq) const {
        unsigned char* ws = ows(P.ws); const float* const* in = P.in; float* out = P.out; const float* xin = l == 0 ? P.in[I_X] : P.out; const float* mod = (const float*)(ws + OFF_MOD) + (size_t)l * 4 * 6144;
        const f16* gates = (const f16*)(ws + OFF_GATES); float* merged = (float*)(ws + OFF_MERGED); f16* mixed = (f16*)(ws + OFF_MIXED);
        switch (kind) {
        case 0: if (EPON(0)) run(EpiProj{ws}, acc, u, wr, wc, fr, fq); break;
        case 1: if (EPON(1)) run(EpiLruGate{(const f16*)(ws + OFF_XA), (f16*)(ws + OFF_LOGA), (f16*)(ws + OFF_U), in[I_LRUBA] + l * 1280, in[I_LRUBX] + l * 1280, (const float*)(ws + OFF_SP) + l * 1280}, acc, u, wr, wc, fr, fq); break;
        case 2: if (EPON(2)) run(EpiLora<0>{(f16*)(ws + OFF_LD), in[I_W0] + l * 1024}, acc, u, wr, wc, fr, fq); break;
        case 3: if (EPON(3)) run(EpiLora<1>{(f16*)(ws + OFF_A), in[I_A0] + l * 1024}, acc, u, wr, wc, fr, fq); break;
        case 4: if (EPON(4)) run(EpiLora<2>{(f16*)(ws + OFF_G), nullptr}, acc, u, wr, wc, fr, fq); break;
        case 5: if (EPON(5)) run(EpiLora<1>{(f16*)(ws + OFF_VMIX), in[I_V0]}, acc, u, wr, wc, fr, fq); break;
        case 6: if (EPON(6)) run(EpiMerge<0>{gates, merged, mixed}, acc, u, wr, wc, fr, fq); break;
        case 7: if (EPON(7)) run(EpiMerge<1>{gates, merged, mixed}, acc, u, wr, wc, fr, fq); break;
        case 8: if (EPON(8)) run(EpiMerge<2>{gates, merged, mixed}, acc, u, wr, wc, fr, fq); break;
        case 9: if (EPON(9)) run(EpiResid{xin, out, mod + 2048, seg}, acc, u, wr, wc, fr, fq); break;
        case 10: if (EPON(10)) run(EpiSwiglu{(f16*)(ws + OFF_FFH)}, acc, u, wr, wc, fr, fq); break;
        default: if (EPON(11)) run(EpiResid{out, out, mod + 5120, seg}, acc, u, wr, wc, fr, fq); break;
        }
    }
};

template <class Src> __device__ __forceinline__ void prep_w(f16* Wt, int N, int K, const Src& src, float* tile) {
    const int tid = otid(), nkt = K / 64, ntile = (N / 64) * nkt;
    for (int t = blockIdx.x; t < ntile; t += gridDim.x) {
        const int n0 = (t / nkt) * 64, k0 = (t % nkt) * 64;
#pragma unroll
        for (int i = 0; i < 8; ++i) { const int kk = (tid >> 6) + 8 * i, nn = tid & 63; tile[kk * 65 + nn] = src(n0 + nn, k0 + kk); }
        __syncthreads();
#pragma unroll
        for (int i = 0; i < 8; ++i) { const int nn = (tid >> 6) + 8 * i, kk = tid & 63; Wt[(size_t)(n0 + nn) * K + k0 + kk] = (f16)tile[kk * 65 + nn]; }
        __syncthreads();
    }
}

__device__ __forceinline__ void phase_prep(const Params& P, int l, float* tile) {
    f16* W = (f16*)(P.ws + OFF_W);
    { const float* w = P.in[I_WIN] + (size_t)l * 1024 * INC; const float* v1 = P.in[I_V1];
      prep_w(W + W_IN, l == 0 ? 10752 : NIN, 1024, [=](int n, int k) -> float {
          int s;
          if (n < 5632) s = n;
          else if (n < 6144) { const int j = n - 5632; s = j < 64 ? 5632 + j : (j >= 128 && j < 192) ? 5696 + (j - 128) : (j >= 256 && j < 416) ? 5760 + (j - 256) : -1; }
          else if (n < 7168) s = 5920 + (n - 6144);
          else if (n < 7680) s = 6944 + (n - 7168);
          else if (n < 10752) s = 7456 + (n - 7680);
          else { const int j = n - 10752; return j < 32 ? v1[(size_t)k * 32 + j] : 0.f; }
          return s < 0 ? 0.f : w[(size_t)k * INC + s]; }, tile); }
    { const float* wa = P.in[I_LRUWA] + (size_t)l * 16 * 6400; const float* wx = P.in[I_LRUWX] + (size_t)l * 16 * 6400;
      prep_w(W + W_LG, 2560, 1280, [=](int n, int k) -> float {
          const int half = (n & 255) >> 7, c = (n >> 8) * 128 + (n & 127), nb = c / 80, jj = c - nb * 80, kb = k / 80, ii = k - kb * 80;
          if (kb != nb) return 0.f;
          return (half ? wx : wa)[(size_t)(nb * 80 + ii) * 80 + jj]; }, tile); }
    { const float* w = P.in[I_WLRUO] + (size_t)l * 1280 * 1024; prep_w(W + W_LO, 1024, 1280, [=](int n, int k) -> float { return w[(size_t)k * 1024 + n]; }, tile); }
    { const float* w = P.in[I_WRWO] + (size_t)l * 1024 * 1024; prep_w(W + W_RO, 1024, 1024, [=](int n, int k) -> float { return w[(size_t)k * 1024 + n]; }, tile); }
    { const float* w = P.in[I_WATTO] + (size_t)l * 1024 * 1024; prep_w(W + W_AO, 1024, 1024, [=](int n, int k) -> float { return w[(size_t)k * 1024 + n]; }, tile); }
    { const float* w = P.in[I_WOUT] + (size_t)l * 1024 * 1024; prep_w(W + W_OUT, 1024, 1024, [=](int n, int k) -> float { return w[(size_t)k * 1024 + n]; }, tile); }
    { const float* w = P.in[I_WFI] + (size_t)l * 1024 * 5632;
      prep_w(W + W_FI, 5632, 1024, [=](int n, int k) -> float { const int half = (n & 255) >> 7, idx = (n >> 8) * 128 + (n & 127); return w[(size_t)k * 5632 + half * 2816 + idx]; }, tile); }
    { const float* w = P.in[I_WFO] + (size_t)l * 2816 * 1024; prep_w(W + W_FO, 1024, 2816, [=](int n, int k) -> float { return w[(size_t)k * 1024 + n]; }, tile); }
    { const float* w = P.in[I_W2] + (size_t)l * 64 * 1024; prep_w(W + W_W2, 1024, 128, [=](int n, int k) -> float { return k < 64 ? w[(size_t)k * 1024 + n] : 0.f; }, tile); }
    { const float* w = P.in[I_A2] + (size_t)l * 64 * 1024; prep_w(W + W_A2, 1024, 128, [=](int n, int k) -> float { return k < 64 ? w[(size_t)k * 1024 + n] : 0.f; }, tile); }
    { const float* w = P.in[I_G2] + (size_t)l * 160 * 1024; prep_w(W + W_G2, 1024, 256, [=](int n, int k) -> float { return k < 160 ? w[(size_t)k * 1024 + n] : 0.f; }, tile); }
    if (l == 1) { const float* w = P.in[I_V2]; prep_w(W + W_V2, 1024, 128, [=](int n, int k) -> float { return k < 32 ? w[(size_t)k * 1024 + n] : 0.f; }, tile); }
}

__device__ __forceinline__ void phase_mod(const Params& P, float* lds) {
    const int tid = otid(), wave = tid >> 6, lane = tid & 63;
    float* sc = lds;
    float* red = lds + 4096;
    const float* c = P.in[I_C];
    for (int i = tid; i < 4096; i += NTHR) { const float v = c[i]; sc[i] = v * sigm(v); }
    __syncthreads();
    float* mod = (float*)(P.ws + OFF_MOD);
    if (blockIdx.x == 0) for (int i = tid; i < 2560; i += NTHR) ((float*)(P.ws + OFF_SP))[i] = log1pf(expf(-P.in[I_LAM][i]));
    for (int it = blockIdx.x; it < 192; it += gridDim.x) {
        const int l = it / 96, n = (it % 96) * 64 + lane;
        const float* w = P.in[I_WADA] + (size_t)l * 1024 * 6144 + n;
        float a0 = 0.f, a1 = 0.f, a2 = 0.f, a3 = 0.f;
        for (int k = wave * 128; k < wave * 128 + 128; ++k) { const float wv = w[(size_t)k * 6144]; a0 += sc[k] * wv; a1 += sc[1024 + k] * wv; a2 += sc[2048 + k] * wv; a3 += sc[3072 + k] * wv; }
        red[(wave * 4 + 0) * 64 + lane] = a0; red[(wave * 4 + 1) * 64 + lane] = a1; red[(wave * 4 + 2) * 64 + lane] = a2; red[(wave * 4 + 3) * 64 + lane] = a3;
        __syncthreads();
        if (tid < 256) { const int b = tid >> 6; float s = P.in[I_BADA][l * 6144 + n];
#pragma unroll
            for (int w8 = 0; w8 < 8; ++w8) s += red[(w8 * 4 + b) * 64 + lane];
            mod[(size_t)(l * 4 + b) * 6144 + n] = s; }
        __syncthreads();
    }
}

__device__ __forceinline__ void phase_norm(const Params& P, const float* xin, int l, int seg, int which  ) {
    const int tid = otid(), lane = tid & 63, gw = blockIdx.x * 8 + (tid >> 6), nw = gridDim.x * 8;
    f16* H = (f16*)(P.ws + OFF_H);
    for (int r = gw; r < MS; r += nw) {
        const size_t g = (size_t)grow(r, seg); const int b = r >> 11;
        const float* mod = (const float*)(P.ws + OFF_MOD) + (size_t)(l * 4 + b) * 6144 + which * 3072;
        f32x4 v[4]; float ss = 0.f;
#pragma unroll
        for (int i = 0; i < 4; ++i) { v[i] = *(const f32x4*)(xin + g * 1024 + i * 256 + lane * 4); ss += v[i][0] * v[i][0] + v[i][1] * v[i][1] + v[i][2] * v[i][2] + v[i][3] * v[i][3]; }
        ss = wave_sum(ss);
        const float rs = rsqrtf(ss * (1.f / 1024.f) + 1e-6f);
#pragma unroll
        for (int i = 0; i < 4; ++i) { const int c = i * 256 + lane * 4; const f32x4 sh = *(const f32x4*)(mod + c), scl = *(const f32x4*)(mod + 1024 + c); f16x4 o;
#pragma unroll
            for (int e = 0; e < 4; ++e) o[e] = (f16)(v[i][e] * rs * (1.f + scl[e]) + sh[e]);
            *(f16x4*)(H + (size_t)r * 1024 + c) = o; }
    }
}

__device__ __forceinline__ void phase_elem(const Params& P, int l, int seg) {
    const int tid = otid(), lane = tid & 63, gt = blockIdx.x * NTHR + tid, ntot = gridDim.x * NTHR, gw = blockIdx.x * 8 + (tid >> 6), nw = gridDim.x * 8;
    unsigned char* ws = ows(P.ws);
    { const f16* X = (const f16*)(ws + OFF_LRUXY); f16* XA = (f16*)(ws + OFF_XA); f16* cw = (f16*)(ws + OFF_CONVC) + (size_t)(seg & 1) * 4 * 3 * 1280; const f16* cr = (const f16*)(ws + OFF_CONVC) + (size_t)((seg + 1) & 1) * 4 * 3 * 1280;
      const float* w = P.in[I_CONVW] + (size_t)l * 4 * 1280; const float* bia = P.in[I_CONVB] + (size_t)l * 1280;
      for (int it = gt; it < MS * 160; it += ntot) {
          const int r = it / 160, c0 = (it % 160) * 8, b = r >> 11, tl = r & 2047;
          float o[8]; ld8g(bia + c0, o);
#pragma unroll
          for (int j = 0; j < 4; ++j) {
              const int t2 = tl - 3 + j; float xv[8];
              if (t2 >= 0) ld8f(X + (size_t)(r - 3 + j) * 2560 + c0, xv);
              else if (seg > 0) ld8f(cr + (size_t)(b * 3 + (3 + t2)) * 1280 + c0, xv);
              else {
#pragma unroll
                  for (int e = 0; e < 8; ++e) xv[e] = 0.f; }
              float wv[8]; ld8g(w + j * 1280 + c0, wv);
#pragma unroll
              for (int e = 0; e < 8; ++e) o[e] += xv[e] * wv[e];
          }
          f16x8 h;
#pragma unroll
          for (int e = 0; e < 8; ++e) h[e] = (f16)o[e];
          *(f16x8*)(XA + (size_t)r * 1280 + c0) = h;
          if (tl >= SEGT - 3) *(f16x8*)(cw + (size_t)(b * 3 + (tl - (SEGT - 3))) * 1280 + c0) = *(const f16x8*)(X + (size_t)r * 2560 + c0);
      } }
    { const f16* X = (const f16*)(ws + OFF_LORAR); f16* AL = (f16*)(ws + OFF_ALORA); f16* cw = (f16*)(ws + OFF_LORAC) + (size_t)(seg & 1) * 4 * 512; const f16* cr = (const f16*)(ws + OFF_LORAC) + (size_t)((seg + 1) & 1) * 4 * 512;
      const float* mu = P.in[I_MU] + (size_t)l * RWC;
      for (int it = gt; it < MS * 64; it += ntot) {
          const int r = it >> 6, c0 = (it & 63) * 8, b = r >> 11, tl = r & 2047;
          const f16x8 raw = *(const f16x8*)(X + (size_t)r * 512 + c0);
          if (tl == SEGT - 1) *(f16x8*)(cw + b * 512 + c0) = raw;
          int mode, mo;
          if (c0 < 64) { mode = 0; mo = 3072 + c0; } else if (c0 >= 128 && c0 < 192) { mode = 1; mo = 3136 + (c0 - 128); } else if (c0 >= 256 && c0 < 416) { mode = 2; mo = 3200 + (c0 - 256); } else { mode = 3; mo = 0; }
          f16x8 o;
          if (mode == 3) {
#pragma unroll
              for (int e = 0; e < 8; ++e) o[e] = (f16)0.f;
          } else {
              float pv[8];
              if (tl > 0) ld8f(X + (size_t)(r - 1) * 512 + c0, pv);
              else if (seg > 0) ld8f(cr + b * 512 + c0, pv);
              else {
#pragma unroll
                  for (int e = 0; e < 8; ++e) pv[e] = 0.f; }
              float mv[8]; ld8g(mu + mo, mv);
#pragma unroll
              for (int e = 0; e < 8; ++e) { const float x = (float)raw[e]; const float p = x + (pv[e] - x) * mv[e]; o[e] = (f16)(mode == 0 ? tanhf(p) : mode == 1 ? p : sigm(p)); }
          }
          *(f16x8*)(AL + (size_t)r * 512 + c0) = o;
      } }
    { f16* Q = (f16*)(ws + OFF_Q); const f16* KV = (const f16*)(ws + OFF_KVRAW); f16* KN = (f16*)(ws + OFF_KN);
      const float* qg = P.in[I_QG] + l * 64; const float* kg = P.in[I_KG] + l * 64;
      for (int r = gw; r < MS; r += nw) {
          float v[16]; ld8f(Q + (size_t)r * 1024 + lane * 16, v); ld8f(Q + (size_t)r * 1024 + lane * 16 + 8, v + 8);
          float ss = 0.f;
#pragma unroll
          for (int e = 0; e < 16; ++e) ss += v[e] * v[e];
          ss += __shfl_xor(ss, 1); ss += __shfl_xor(ss, 2);
          const float rs = rsqrtf(ss * (1.f / 64.f) + 1e-6f) * 0.125f;
          float gv[16]; ld8g(qg + (lane & 3) * 16, gv); ld8g(qg + (lane & 3) * 16 + 8, gv + 8);
          f16x8 o0, o1;
#pragma unroll
          for (int e = 0; e < 8; ++e) { o0[e] = (f16)(v[e] * rs * gv[e]); o1[e] = (f16)(v[8 + e] * rs * gv[8 + e]); }
          *(f16x8*)(Q + (size_t)r * 1024 + lane * 16) = o0; *(f16x8*)(Q + (size_t)r * 1024 + lane * 16 + 8) = o1;
          const f16x4 kr = *(const f16x4*)(KV + (size_t)r * 512 + lane * 4);
          float kv[4] = {(float)kr[0], (float)kr[1], (float)kr[2], (float)kr[3]};
          float s2 = kv[0] * kv[0] + kv[1] * kv[1] + kv[2] * kv[2] + kv[3] * kv[3];
          s2 += __shfl_xor(s2, 1); s2 += __shfl_xor(s2, 2); s2 += __shfl_xor(s2, 4); s2 += __shfl_xor(s2, 8);
          const float rk = rsqrtf(s2 * (1.f / 64.f) + 1e-6f);
          const f32x4 kgv = *(const f32x4*)(kg + (lane & 15) * 4);
          f16x4 ko; ko[0] = (f16)(kv[0] * rk * kgv[0]); ko[1] = (f16)(kv[1] * rk * kgv[1]); ko[2] = (f16)(kv[2] * rk * kgv[2]); ko[3] = (f16)(kv[3] * rk * kgv[3]);
          *(f16x4*)(KN + (size_t)grow(r, seg) * 256 + lane * 4) = ko;
      } }
    { const f16* KV = (const f16*)(ws + OFF_KVRAW); f16* VT = (f16*)(ws + OFF_VT);
      for (int it = gw; it < (MS / 64) * 4; it += nw) {
          const int tile = it >> 2, kvh = it & 3, r0 = tile * 64, b = r0 >> 11, pos0 = seg * SEGT + (r0 & 2047);
          f16x8 vv[8];
#pragma unroll
          for (int i = 0; i < 8; ++i)
#pragma unroll
              for (int e = 0; e < 8; ++e) vv[i][e] = KV[(size_t)(r0 + i * 8 + e) * 512 + 256 + kvh * 64 + lane];
          f16* dst = VT + ((size_t)((b * 4 + kvh) * 64 + lane)) * SEQ + pos0;
#pragma unroll
          for (int i = 0; i < 8; ++i) *(f16x8*)(dst + i * 8) = vv[i];
      } }
}

__device__ __forceinline__ void phase_rwprep(const Params& P, int l, int seg) {
    const int tid = otid(), lane = tid & 63, gw = blockIdx.x * 8 + (tid >> 6), nw = gridDim.x * 8;
    unsigned char* ws = ows(P.ws);
    const f16* X = (const f16*)(ws + OFF_RKV); const f16* A = (const f16*)(ws + OFF_A); const f16* VM = (const f16*)(ws + OFF_VMIX); f16* VF = (f16*)(ws + OFF_VFIRST);
    f16* R = (f16*)(ws + OFF_R); f16* K = (f16*)(ws + OFF_K); f16* V = (f16*)(ws + OFF_V); f16* KK = (f16*)(ws + OFF_KK);
    f16* cw = (f16*)(ws + OFF_RKVC) + (size_t)(seg & 1) * 4 * 3072; const f16* cr = (const f16*)(ws + OFF_RKVC) + (size_t)((seg + 1) & 1) * 4 * 3072;
    const float* mu = P.in[I_MU] + (size_t)l * RWC; const float* kkw = P.in[I_KK] + l * 1024; const float* kaw = P.in[I_KA] + l * 1024;
    for (int r = gw; r < MS; r += nw) {
        const int b = r >> 11, tl = r & 2047, c = lane * 16; const size_t g = (size_t)grow(r, seg);
        float x[3][16];
#pragma unroll
        for (int j = 0; j < 3; ++j) {
            const f16x8 r0 = *(const f16x8*)(X + (size_t)r * 3072 + j * 1024 + c), r1 = *(const f16x8*)(X + (size_t)r * 3072 + j * 1024 + c + 8);
            if (tl == SEGT - 1) { *(f16x8*)(cw + b * 3072 + j * 1024 + c) = r0; *(f16x8*)(cw + b * 3072 + j * 1024 + c + 8) = r1; }
            float pv[16];
            if (tl > 0) { ld8f(X + (size_t)(r - 1) * 3072 + j * 1024 + c, pv); ld8f(X + (size_t)(r - 1) * 3072 + j * 1024 + c + 8, pv + 8); }
            else if (seg > 0) { ld8f(cr + b * 3072 + j * 1024 + c, pv); ld8f(cr + b * 3072 + j * 1024 + c + 8, pv + 8); }
            else {
#pragma unroll
                for (int e = 0; e < 16; ++e) pv[e] = 0.f; }
            float mv[16]; ld8g(mu + j * 1024 + c, mv); ld8g(mu + j * 1024 + c + 8, mv + 8);
#pragma unroll
            for (int e = 0; e < 16; ++e) { const float xv = e < 8 ? (float)r0[e & 7] : (float)r1[e & 7]; x[j][e] = xv + (pv[e] - xv) * mv[e]; }
        }
        if (l == 0) { f16x8 o0, o1;
#pragma unroll
            for (int e = 0; e < 8; ++e) { o0[e] = (f16)x[2][e]; o1[e] = (f16)x[2][8 + e]; }
            *(f16x8*)(VF + g * 1024 + c) = o0; *(f16x8*)(VF + g * 1024 + c + 8) = o1;
        } else { float vf[16], vm[16]; ld8f(VF + g * 1024 + c, vf); ld8f(VF + g * 1024 + c + 8, vf + 8); ld8f(VM + (size_t)r * 1024 + c, vm); ld8f(VM + (size_t)r * 1024 + c + 8, vm + 8);
#pragma unroll
            for (int e = 0; e < 16; ++e) x[2][e] = x[2][e] + (vf[e] - x[2][e]) * vm[e]; }
        float av[16], kkv[16], kav[16], kk[16];
        ld8f(A + (size_t)r * 1024 + c, av); ld8f(A + (size_t)r * 1024 + c + 8, av + 8);
        ld8g(kkw + c, kkv); ld8g(kkw + c + 8, kkv + 8); ld8g(kaw + c, kav); ld8g(kaw + c + 8, kav + 8);
        float ss = 0.f;
#pragma unroll
        for (int e = 0; e < 16; ++e) { kk[e] = x[1][e] * kkv[e]; ss += kk[e] * kk[e]; }
        ss += __shfl_xor(ss, 1); ss += __shfl_xor(ss, 2);
        const float rn = rsqrtf(fmaxf(ss, 1e-24f));
        f16x8 oR0, oR1, oK0, oK1, oV0, oV1, oQ0, oQ1;
#pragma unroll
        for (int e = 0; e < 8; ++e) {
            oR0[e] = (f16)x[0][e]; oR1[e] = (f16)x[0][8 + e];
            oK0[e] = (f16)(x[1][e] * (1.f + (av[e] - 1.f) * kav[e])); oK1[e] = (f16)(x[1][8 + e] * (1.f + (av[8 + e] - 1.f) * kav[8 + e]));
            oV0[e] = (f16)x[2][e]; oV1[e] = (f16)x[2][8 + e];
            oQ0[e] = (f16)(kk[e] * rn); oQ1[e] = (f16)(kk[8 + e] * rn);
        }
        const size_t o = (size_t)r * 1024 + c;
        *(f16x8*)(R + o) = oR0; *(f16x8*)(R + o + 8) = oR1; *(f16x8*)(K + o) = oK0; *(f16x8*)(K + o + 8) = oK1;
        *(f16x8*)(V + o) = oV0; *(f16x8*)(V + o + 8) = oV1; *(f16x8*)(KK + o) = oQ0; *(f16x8*)(KK + o + 8) = oQ1;
    }
}

__device__ __forceinline__ void phase_rwscan(const Params& P, int seg, float* lds) {
    const int tid = otid(), lane = tid & 63, wave = tid >> 6;
    unsigned char* ws = ows(P.ws);
    const f16* R = (const f16*)(ws + OFF_R); const f16* K = (const f16*)(ws + OFF_K); const f16* V = (const f16*)(ws + OFF_V); const f16* KK = (const f16*)(ws + OFF_KK);
    const f16* A = (const f16*)(ws + OFF_A); const f16* LD = (const f16*)(ws + OFF_LD); f16* Y = (f16*)(ws + OFF_Y);
    float* buf = lds;
    float* vbuf = lds + 2 * 5 * 2048;
    float* yp = vbuf + 2 * 512;
    constexpr int NCH = SEGT / 32;
    for (int item = blockIdx.x; item < 256; item += gridDim.x) {
        const int b = item >> 6, h = (item >> 2) & 15, rg = item & 3;
        const size_t rowbase = (size_t)b * SEGT;
        float* st = (float*)(ws + OFF_STATE) + ((size_t)item * 256 + (tid & 255)) * 4;
        f32x4 S = (f32x4){0.f, 0.f, 0.f, 0.f};
        if (wave < 4 && seg > 0) S = *(const f32x4*)st;
        const int ks = (lane & 15) * 4, rr = lane >> 4;
        auto load_chunk = [&](int c) {
            const int lt = tid - 256, p = c & 1, tt = lt >> 3, c8 = (lt & 7) * 8;
            const size_t o = (rowbase + c * 32 + tt) * 1024 + h * 64 + c8;
            float r8[8], k8[8], q8[8], a8[8], d8[8];
            ld8f(R + o, r8); ld8f(K + o, k8); ld8f(KK + o, q8); ld8f(A + o, a8); ld8f(LD + o, d8);
            float* bp = buf + p * 5 * 2048 + tt * 64 + c8;
#pragma unroll
            for (int e = 0; e < 8; ++e) { bp[e] = __expf(d8[e]); bp[2048 + e] = k8[e]; bp[2 * 2048 + e] = -q8[e]; bp[3 * 2048 + e] = q8[e] * a8[e]; bp[4 * 2048 + e] = r8[e]; }
            if (lt < 64) { const int t2 = lt >> 1, hf = lt & 1; float v8[8]; ld8f(V + (rowbase + c * 32 + t2) * 1024 + h * 64 + rg * 16 + hf * 8, v8);
#pragma unroll
                for (int e = 0; e < 8; ++e) vbuf[p * 512 + t2 * 16 + hf * 8 + e] = v8[e]; }
        };
        auto drain_chunk = [&](int c) {
            const int lt = tid - 256, p = c & 1;
#pragma unroll
            for (int i = 0; i < 2; ++i) {
                const int o = lt + i * 256, tok = o >> 4, ri = o & 15;
                const float* yy = yp + p * 8192 + tok * 256 + (ri >> 2) * 64 + (ri & 3) * 16;
                const f32x4 s0 = *(const f32x4*)yy, s1 = *(const f32x4*)(yy + 4), s2 = *(const f32x4*)(yy + 8), s3 = *(const f32x4*)(yy + 12);
                const float s = ((s0[0] + s0[1]) + (s0[2] + s0[3])) + ((s1[0] + s1[1]) + (s1[2] + s1[3])) + ((s2[0] + s2[1]) + (s2[2] + s2[3])) + ((s3[0] + s3[1]) + (s3[2] + s3[3]));
                Y[(rowbase + c * 32 + tok) * 1024 + h * 64 + rg * 16 + ri] = (f16)s;
            }
        };
        if (wave >= 4) load_chunk(0);
        __syncthreads();
        for (int c = 0; c < NCH; ++c) {
            if (wave < 4) {
                const int p = c & 1;
                const float* bp = buf + p * 5 * 2048 + ks; const float* vp = vbuf + p * 512 + wave * 4 + rr; float* yo = yp + p * 8192 + wave * 64 + lane;
#pragma unroll 4
                for (int t = 0; t < 32; ++t) {
                    const f32x4 w4 = *(const f32x4*)(bp + t * 64), k4 = *(const f32x4*)(bp + 2048 + t * 64), a4 = *(const f32x4*)(bp + 4096 + t * 64), b4 = *(const f32x4*)(bp + 6144 + t * 64), r4 = *(const f32x4*)(bp + 8192 + t * 64);
                    const float v = vp[t * 16];
                    float sa = (S[0] * a4[0] + S[1] * a4[1]) + (S[2] * a4[2] + S[3] * a4[3]);
                    sa = red16(sa);
                    S[0] = S[0] * w4[0] + (sa * b4[0] + v * k4[0]); S[1] = S[1] * w4[1] + (sa * b4[1] + v * k4[1]);
                    S[2] = S[2] * w4[2] + (sa * b4[2] + v * k4[2]); S[3] = S[3] * w4[3] + (sa * b4[3] + v * k4[3]);
                    yo[t * 256] = (S[0] * r4[0] + S[1] * r4[1]) + (S[2] * r4[2] + S[3] * r4[3]);
                }
            } else {
                if (c + 1 < NCH) load_chunk(c + 1);
                if (c > 0) drain_chunk(c - 1);
            }
            __syncthreads();
        }
        if (wave >= 4) drain_chunk(NCH - 1);
        if (wave < 4) *(f32x4*)st = S;
        __syncthreads();
    }
}

__device__ __forceinline__ float gelu_tanh(float x) { const float u = 0.7978845608028654f * (x + 0.044715f * x * x * x); const float t = 1.f - 2.f / (1.f + __expf(2.f * u)); return 0.5f * x * (1.f + t); }

__device__ __forceinline__ void phase_mix(const Params& P, int l, int seg, float* lds) {
    const int tid = otid(), lane = tid & 63, wave = tid >> 6, gw = blockIdx.x * 8 + wave, nw = gridDim.x * 8;
    unsigned char* ws = ows(P.ws);
    { const f16* LA = (const f16*)(ws + OFF_LOGA); const f16* U = (const f16*)(ws + OFF_U); const f16* XY = (const f16*)(ws + OFF_LRUXY); f16* YA = (f16*)(ws + OFF_YA); float* HC = (float*)(ws + OFF_HC);
      float* Ls = lds; float* Hs = lds + 512;
      for (int item = blockIdx.x; item < 160; item += gridDim.x) {
          const int b = item / 40, c = (item % 40) * 32 + (tid & 31), tc = tid >> 5;
          const size_t r0 = (size_t)b * SEGT + tc * 128;
          float L = 0.f, H = 0.f;
          for (int s = 0; s < 128; ++s) { const float la = (float)LA[(r0 + s) * LRUW + c], u = (float)U[(r0 + s) * LRUW + c]; H = __expf(la) * H + u; L += la; }
          Ls[tc * 32 + (tid & 31)] = L; Hs[tc * 32 + (tid & 31)] = H;
          __syncthreads();
          float hin = seg > 0 ? HC[b * LRUW + c] : 0.f;
          for (int j = 0; j < tc; ++j) hin = __expf(Ls[j * 32 + (tid & 31)]) * hin + Hs[j * 32 + (tid & 31)];
          __syncthreads();
          H = hin;
          for (int s = 0; s < 128; ++s) { const float la = (float)LA[(r0 + s) * LRUW + c], u = (float)U[(r0 + s) * LRUW + c]; H = __expf(la) * H + u;
              const float y = (float)XY[(r0 + s) * 2560 + 1280 + c]; YA[(r0 + s) * LRUW + c] = (f16)(H * gelu_tanh(y)); }
          if (tc == 15) HC[b * LRUW + c] = H;
          __syncthreads();
      } }
    { const f16* Y = (const f16*)(ws + OFF_Y); const f16* R = (const f16*)(ws + OFF_R); const f16* K = (const f16*)(ws + OFF_K); const f16* V = (const f16*)(ws + OFF_V); const f16* G = (const f16*)(ws + OFF_G); f16* YB = (f16*)(ws + OFF_YB);
      const float* rk = P.in[I_RK] + l * 1024; const float* lw = P.in[I_LNW] + l * 1024; const float* lb = P.in[I_LNB] + l * 1024;
      for (int r = gw; r < MS; r += nw) {
          const size_t o = (size_t)r * 1024 + lane * 16; const int c = lane * 16;
          float y[16], rv[16], kv[16], vv[16], gv[16], rkv[16], lwv[16], lbv[16];
          ld8f(Y + o, y); ld8f(Y + o + 8, y + 8); ld8f(R + o, rv); ld8f(R + o + 8, rv + 8); ld8f(K + o, kv); ld8f(K + o + 8, kv + 8); ld8f(V + o, vv); ld8f(V + o + 8, vv + 8); ld8f(G + o, gv); ld8f(G + o + 8, gv + 8);
          ld8g(rk + c, rkv); ld8g(rk + c + 8, rkv + 8); ld8g(lw + c, lwv); ld8g(lw + c + 8, lwv + 8); ld8g(lb + c, lbv); ld8g(lb + c + 8, lbv + 8);
          float s = 0.f, bo = 0.f;
#pragma unroll
          for (int e = 0; e < 16; ++e) { s += y[e]; bo += rv[e] * kv[e] * rkv[e]; }
          s += __shfl_xor(s, 1); s += __shfl_xor(s, 2); bo += __shfl_xor(bo, 1); bo += __shfl_xor(bo, 2);
          const float mean = s * (1.f / 64.f); float q = 0.f;
#pragma unroll
          for (int e = 0; e < 16; ++e) { const float d = y[e] - mean; q += d * d; }
          q += __shfl_xor(q, 1); q += __shfl_xor(q, 2);
          const float rs = rsqrtf(q * (1.f / 64.f) + 64e-5f);
          f16x8 o0, o1;
#pragma unroll
          for (int e = 0; e < 16; ++e) { const float v = ((y[e] - mean) * rs * lwv[e] + lbv[e] + bo * vv[e]) * gv[e]; if (e < 8) o0[e] = (f16)v; else o1[e - 8] = (f16)v; }
          *(f16x8*)(YB + o) = o0; *(f16x8*)(YB + o + 8) = o1;
      } }
    { f16* Q = (f16*)(ws + OFF_Q); const f16* KN = (const f16*)(ws + OFF_KN); const f16* VT = (const f16*)(ws + OFF_VT);
      const float* sinks = P.in[I_SINK] + l * 16;
      const int qi = lane & 15, quad = lane >> 4;
      for (int u = gw; u < (MS / 16) * 16; u += nw) {
          const int tile = u >> 4, h = u & 15, kvh = h >> 2, r0 = tile * 16, b = r0 >> 11, pos0 = seg * SEGT + (r0 & 2047);
          const f16* qp = Q + (size_t)(r0 + qi) * 1024 + h * 64 + quad * 8;
          const f16x8 qf0 = *(const f16x8*)qp, qf1 = *(const f16x8*)(qp + 32);
          f32x4 sc[10];
          const int qpos = pos0 + qi;
#pragma unroll
          for (int tt = 0; tt < 10; ++tt) {
              const int ks0 = pos0 - 144 + 16 * tt;
              if (tt == 0 || ks0 < 0) { sc[tt] = (f32x4){-1e30f, -1e30f, -1e30f, -1e30f}; continue; }
              const f16* kp = KN + ((size_t)b * SEQ + ks0 + qi) * 256 + kvh * 64 + quad * 8;
              const f16x8 kf0 = *(const f16x8*)kp, kf1 = *(const f16x8*)(kp + 32);
              f32x4 s = (f32x4){0.f, 0.f, 0.f, 0.f};
              s = __builtin_amdgcn_mfma_f32_16x16x32_f16(kf0, qf0, s, 0, 0, 0);
              s = __builtin_amdgcn_mfma_f32_16x16x32_f16(kf1, qf1, s, 0, 0, 0);
#pragma unroll
              for (int j = 0; j < 4; ++j) { const int kpos = ks0 + quad * 4 + j; const bool ok = (kpos <= qpos) && (qpos - kpos < 128); s[j] = ok ? s[j] : -1e30f; }
              sc[tt] = s;
          }
          float m = -1e30f;
#pragma unroll
          for (int tt = 0; tt < 10; ++tt) m = fmaxf(m, fmaxf(fmaxf(sc[tt][0], sc[tt][1]), fmaxf(sc[tt][2], sc[tt][3])));
          m = fmaxf(m, __shfl_xor(m, 16)); m = fmaxf(m, __shfl_xor(m, 32));
          const float sink = sinks[h]; m = fmaxf(m, sink);
          float sum = 0.f;
#pragma unroll
          for (int tt = 0; tt < 10; ++tt)
#pragma unroll
              for (int j = 0; j < 4; ++j) { const float e = __expf(sc[tt][j] - m); sc[tt][j] = e; sum += e; }
          sum += __shfl_xor(sum, 16); sum += __shfl_xor(sum, 32);
          const float inv = 1.f / (sum + __expf(sink - m));
          f32x4 o[4];
#pragma unroll
          for (int dt = 0; dt < 4; ++dt) o[dt] = (f32x4){0.f, 0.f, 0.f, 0.f};
#pragma unroll
          for (int gI = 0; gI < 5; ++gI) {
              const int ksA = pos0 - 144 + 32 * gI, ksB = ksA + 16;
              const bool okA = (gI > 0) && ksA >= 0, okB = ksB >= 0;
              if (!okB) continue;
              f16x8 pf;
#pragma unroll
              for (int j = 0; j < 4; ++j) { pf[j] = (f16)(sc[2 * gI][j] * inv); pf[4 + j] = (f16)(sc[2 * gI + 1][j] * inv); }
#pragma unroll
              for (int dt = 0; dt < 4; ++dt) {
                  const f16* vp = VT + ((size_t)((b * 4 + kvh) * 64 + dt * 16 + qi)) * SEQ + quad * 4;
                  f16x4 va = (f16x4){(f16)0.f, (f16)0.f, (f16)0.f, (f16)0.f};
                  if (okA) va = *(const f16x4*)(vp + ksA);
                  const f16x4 vb = *(const f16x4*)(vp + ksB);
                  f16x8 vf; vf[0] = va[0]; vf[1] = va[1]; vf[2] = va[2]; vf[3] = va[3]; vf[4] = vb[0]; vf[5] = vb[1]; vf[6] = vb[2]; vf[7] = vb[3];
                  o[dt] = __builtin_amdgcn_mfma_f32_16x16x32_f16(vf, pf, o[dt], 0, 0, 0);
              }
          }
          f16* op = Q + (size_t)(r0 + qi) * 1024 + h * 64 + quad * 4;
#pragma unroll
          for (int dt = 0; dt < 4; ++dt) { f16x4 ov; ov[0] = (f16)o[dt][0]; ov[1] = (f16)o[dt][1]; ov[2] = (f16)o[dt][2]; ov[3] = (f16)o[dt][3]; *(f16x4*)(op + dt * 16) = ov; }
      } }
}

constexpr int PH_PER_SEG = 12, PH_PER_LAYER = 1 + NSEG * PH_PER_SEG, N_PHASES = 1 + 2 * PH_PER_LAYER;

struct Job { const f16* A; const f16* Bt; int lda, ldb, nt, N, cshift, kind, lru; };
__device__ __forceinline__ int gemm_jobs(int sub, int l) { return sub == 1 ? 1 : sub == 3 ? (l == 1 ? 5 : 4) : sub == 7 ? 3 : (sub == 8 || sub == 10 || sub == 11) ? 1 : 0; }
__device__ __forceinline__ Job make_job(unsigned char* ws, int sub, int j, int l) {
    const f16* W = (const f16*)(ws + OFF_W);
    switch (sub) {
    case 1: return Job{(const f16*)(ws + OFF_H), W + W_IN, 1024, 1024, 16, l == 0 ? 10752 : NIN, 0, 0, 0};
    case 3:
        switch (j) {
        case 0: return Job{(const f16*)(ws + OFF_XA), W + W_LG, 1280, 1280, 4, 2560, 0, 1, 1};
        case 1: return Job{(const f16*)(ws + OFF_ALORA), W + W_W2, 512, 128, 2, 1024, 64, 2, 0};
        case 2: return Job{(const f16*)(ws + OFF_ALORA) + 128, W + W_A2, 512, 128, 2, 1024, 192, 3, 0};
        case 3: return Job{(const f16*)(ws + OFF_ALORA) + 256, W + W_G2, 512, 256, 4, 1024, 128, 4, 0};
        default: return Job{(const f16*)(ws + OFF_V1O), W + W_V2, 256, 128, 2, 1024, 0, 5, 0};
        }
    case 7:
        switch (j) {
        case 0: return Job{(const f16*)(ws + OFF_YA), W + W_LO, 1280, 1280, 20, 1024, 0, 6, 0};
        case 1: return Job{(const f16*)(ws + OFF_YB), W + W_RO, 1024, 1024, 16, 1024, 0, 7, 0};
        default: return Job{(const f16*)(ws + OFF_Q), W + W_AO, 1024, 1024, 16, 1024, 0, 8, 0};
        }
    case 8: return Job{(const f16*)(ws + OFF_MIXED), W + W_OUT, 1024, 1024, 16, 1024, 0, 9, 0};
    case 10: return Job{(const f16*)(ws + OFF_H), W + W_FI, 1024, 1024, 16, 5632, 0, 10, 0};
    default: return Job{(const f16*)(ws + OFF_FFH), W + W_FO, DFF, DFF, 44, 1024, 0, 11, 0};
    }
}

__global__ void __launch_bounds__(NTHR) fwd_kernel(Params P) {
    extern __shared__ __attribute__((aligned(16))) unsigned char smem[];
    LAS unsigned char* lds = (LAS unsigned char*)smem;
    float* ldsf = (float*)smem;
    unsigned char* ws = ows(P.ws);
    const int G = gridDim.x, cid = blockIdx.x;
    for (int ph = P.ph_lo; ph < P.ph_hi; ++ph) {
        if (ph == 0) { if (PHON(12)) phase_mod(P, ldsf); }
        else {
            const int p = ph - 1, l = p / PH_PER_LAYER, q = p % PH_PER_LAYER;
            const float* xin = l == 0 ? P.in[I_X] : P.out;
            if (q == 0) { if (PHON(13)) phase_prep(P, l, ldsf); }
            else {
                const int seg = (q - 1) / PH_PER_SEG, sub = (q - 1) % PH_PER_SEG;
                const int nj = gemm_jobs(sub, l);
                if (nj > 0) {
                    if (PHON(1)) for (int j = 0; j < nj; ++j) {
                        const Job jb = make_job(ws, sub, j, l);
                        pg8::Gemm g{jb.A, jb.Bt, jb.lda, jb.ldb, jb.nt}; pg8::StaticOrder S; S.init(MS, jb.N, G, (cid + jb.cshift) % G, jb.lru);
                        EpiDispatch ED{jb.kind, P, l, seg};
                        pg8::gemm_phase(lds, g, S, ED);
                    }
                } else {
                    switch (sub) {
                    case 0: if (PHON(0)) phase_norm(P, xin, l, seg, 0); break;
                    case 2: if (PHON(2)) phase_elem(P, l, seg); break;
                    case 4: if (PHON(4)) phase_rwprep(P, l, seg); break;
                    case 5: if (PHON(5)) phase_rwscan(P, seg, ldsf); break;
                    case 6: if (PHON(6)) phase_mix(P, l, seg, ldsf); break;
                    default: if (PHON(9)) phase_norm(P, P.out, l, seg, 1); break;
                    }
                }
            }
        }
        if (P.coop && ph + 1 < P.ph_hi) cg::this_grid().sync();
    }
}

extern "C" void kernel_launch(void* const* d_in, const int* in_sizes, int n_in, void* d_out, int out_size, void* d_ws, size_t ws_size, hipStream_t stream) {
    static int grid = 0;
    if (grid == 0) {
        int dev = 0, cus = 0, per_cu = 0;
        hipGetDevice(&dev); hipDeviceGetAttribute(&cus, hipDeviceAttributeMultiprocessorCount, dev);
        hipFuncSetAttribute((const void*)fwd_kernel, hipFuncAttributeMaxDynamicSharedMemorySize, LDS_BYTES);
        hipOccupancyMaxActiveBlocksPerMultiprocessor(&per_cu, (const void*)fwd_kernel, NTHR, LDS_BYTES);
        if (per_cu < 1) per_cu = 1;
        grid = cus * per_cu;
        if (n_in != 35 || ws_size < WS_END) { fprintf(stderr, "kernel_launch: unexpected n_in %d / ws_size %zu\n", n_in, ws_size); grid = -1; }
    }
    if (grid < 0) return;
    Params p{};
    for (int i = 0; i < 35; ++i) p.in[i] = (const float*)d_in[i];
    p.out = (float*)d_out; p.ws = (unsigned char*)d_ws;
#if COOP
    p.ph_lo = 0; p.ph_hi = N_PHASES; p.coop = 1;
    void* args[] = {&p};
    hipError_t e = hipLaunchCooperativeKernel((const void*)fwd_kernel, dim3(grid), dim3(NTHR), args, LDS_BYTES, stream);
    if (e != hipSuccess) fprintf(stderr, "cooperative launch failed: %s (grid %d)\n", hipGetErrorString(e), grid);
#else
    for (int ph = 0; ph < N_PHASES; ++ph) {
        p.ph_lo = ph; p.ph_hi = ph + 1; p.coop = 0;
        hipLaunchKernelGGL(fwd_kernel, dim3(grid), dim3(NTHR), LDS_BYTES, stream, p);
    }
#endif
}
```

```cpp
#include <hip/hip_runtime.h>
#include <hip/hip_cooperative_groups.h>
#include <cstdio>
#include <cstdint>
namespace cg = cooperative_groups;

#ifndef COOP
#define COOP 1
#endif
#ifndef PROBE
#define PROBE 0
#endif
#ifndef PC1
#define PC1 0
#endif
#ifndef PC2
#define PC2 1
#endif
#ifndef DUP_SUB
#define DUP_SUB -1
#endif
#ifndef DUP_SYNC
#define DUP_SYNC 0
#endif
#ifndef PHMASK
#define PHMASK 0xFFFF
#endif
#define PHON(i) ((PHMASK >> (i)) & 1)
#ifndef TSEL
#define TSEL 0xFF
#endif
#define TS(i) ((TSEL >> (i)) & 1)
#ifndef EPIMASK
#define EPIMASK 0xFFFF
#endif
#define EPON(i) ((EPIMASK >> (i)) & 1)

#define LAS __attribute__((address_space(3)))
typedef _Float16 f16;
typedef _Float16 f16x8 __attribute__((ext_vector_type(8)));
typedef _Float16 f16x4 __attribute__((ext_vector_type(4)));
typedef float f32x4 __attribute__((ext_vector_type(4)));
typedef float f32x2 __attribute__((ext_vector_type(2)));

constexpr int NB = 4, SEQ = 8192, DM = 1024, TT = NB * SEQ;
constexpr int SEGT = 2048, NSEG = SEQ / SEGT, MS = NB * SEGT;
constexpr int LRUW = 1280, DFF = 2816, INC = 10528, RWC = 3360;
constexpr int NIN = 11008;
constexpr int NTHR = 512;
constexpr int LDS_BYTES = 155648;

constexpr size_t MiB = 1u << 20;
constexpr size_t OFF_MOD = 0;
constexpr size_t OFF_CONVC = 256 * 1024;
constexpr size_t OFF_RKVC = 384 * 1024;
constexpr size_t OFF_LORAC = 512 * 1024;
constexpr size_t OFF_HC = 640 * 1024;
constexpr size_t OFF_BAR = 768 * 1024;
constexpr size_t OFF_SP = 704 * 1024;
constexpr size_t OFF_STATE = 1 * MiB;
constexpr size_t OFF_W = 2 * MiB;
constexpr size_t OFF_VFIRST = 58 * MiB;
constexpr size_t OFF_KN = 122 * MiB;
constexpr size_t OFF_VT = 138 * MiB;
constexpr size_t OFF_H = 154 * MiB;
constexpr size_t OFF_LRUXY = 170 * MiB;
constexpr size_t OFF_RKV = 210 * MiB;
constexpr size_t OFF_LORAR = 258 * MiB;
constexpr size_t OFF_ALORA = 266 * MiB;
constexpr size_t OFF_Q = 274 * MiB;
constexpr size_t OFF_KVRAW = 290 * MiB;
constexpr size_t OFF_GATES = 298 * MiB;
constexpr size_t OFF_V1O = 346 * MiB;
constexpr size_t OFF_XA = 350 * MiB;
constexpr size_t OFF_LOGA = 370 * MiB;
constexpr size_t OFF_U = 390 * MiB;
constexpr size_t OFF_LD = 410 * MiB;
constexpr size_t OFF_A = 426 * MiB;
constexpr size_t OFF_G = 442 * MiB;
constexpr size_t OFF_VMIX = 458 * MiB;
constexpr size_t OFF_KK = 474 * MiB;
constexpr size_t OFF_R = OFF_H, OFF_K = OFF_LORAR, OFF_V = OFF_XA, OFF_YA = OFF_RKV, OFF_Y = 230 * MiB, OFF_FFH = OFF_LRUXY;
constexpr size_t OFF_MERGED = OFF_LD, OFF_MIXED = OFF_G, OFF_YB = OFF_VMIX;
constexpr size_t OFF_AGG = 56 * MiB;
constexpr size_t OFF_HN = 490 * MiB;
constexpr size_t WS_END = 506 * MiB;
constexpr size_t W_IN = 0, W_LG = W_IN + (size_t)NIN * 1024, W_LO = W_LG + 2560 * 1280, W_RO = W_LO + 1024 * 1280, W_AO = W_RO + 1024 * 1024, W_OUT = W_AO + 1024 * 1024,
                 W_FI = W_OUT + 1024 * 1024, W_FO = W_FI + 5632 * 1024, W_W2 = W_FO + 1024 * 2816, W_A2 = W_W2 + 1024 * 128, W_G2 = W_A2 + 1024 * 128, W_V2 = W_G2 + 1024 * 256, W_TOT = W_V2 + 1024 * 128;
static_assert(W_TOT * 2 <= 56 * MiB, "weights");

struct Params { const float* in[35]; float* out; unsigned char* ws; int ph_lo, ph_hi; int coop; int pad; };
enum { I_X = 0, I_C, I_WADA, I_BADA, I_WIN, I_CONVW, I_CONVB, I_LRUWA, I_LRUBA, I_LRUWX, I_LRUBX, I_LAM, I_WLRUO, I_MU, I_W0, I_W2, I_A0, I_A2, I_G2, I_KK, I_KA, I_RK, I_LNW, I_LNB,
       I_V0, I_V1, I_V2, I_WRWO, I_QG, I_KG, I_SINK, I_WATTO, I_WOUT, I_WFI, I_WFO };

__device__ __forceinline__ int otid() { int t = threadIdx.x; asm volatile("" : "+v"(t)); return t; }
__device__ __forceinline__ unsigned char* ows(unsigned char* p) { asm volatile("" : "+s"(p)); return p; }
__device__ __forceinline__ float gelu_tanh(float x) { const float u = 0.7978845608028654f * (x + 0.044715f * x * x * x); const float t = 1.f - 2.f / (1.f + __expf(2.f * u)); return 0.5f * x * (1.f + t); }
__device__ __forceinline__ float sigm(float x) { return 1.f / (1.f + __expf(-x)); }
__device__ __forceinline__ float wave_sum(float v) {
#pragma unroll
    for (int o = 1; o < 64; o <<= 1) v += __shfl_xor(v, o);
    return v;
}
template <int CTRL> __device__ __forceinline__ float dppf(float x) { return __builtin_bit_cast(float, __builtin_amdgcn_update_dpp(0, __builtin_bit_cast(int, x), CTRL, 0xf, 0xf, false)); }
__device__ __forceinline__ float red16(float x) { x += dppf<0x128>(x); x += dppf<0x124>(x); x += dppf<0x122>(x); x += dppf<0x121>(x); return x; }
__device__ __forceinline__ int grow(int r, int seg) { return (r >> 11) * SEQ + seg * SEGT + (r & (SEGT - 1)); }

#define XB_TMO      128
#define XB_XCNT(j)  (256  + 64 * (j))
#define XB_XSUB(j)  (1280 + 64 * (j))
#define XB_XGEN(j)  (2304 + 64 * (j))
#define XB_TOP      3328
#define XB_TOPGEN   3392
#define XCD_BAR_WORDS 3456
#define XB_SPIN_CAP (1u << 18)

__device__ __forceinline__ unsigned xb_ld(unsigned* p)              { return __hip_atomic_load(p, __ATOMIC_RELAXED, __HIP_MEMORY_SCOPE_AGENT); }
__device__ __forceinline__ unsigned xb_add(unsigned* p, unsigned v) { return __hip_atomic_fetch_add(p, v, __ATOMIC_RELAXED, __HIP_MEMORY_SCOPE_AGENT); }
__device__ __forceinline__ unsigned xb_xcc_id() { return (unsigned)__builtin_amdgcn_s_getreg((3 << 11) | 20) & 0xFu; }
#define XB_SPIN(cond, bar) do { unsigned _sp = 0; while (cond) { __builtin_amdgcn_s_sleep(1); \
    if ((++_sp & 255u) == 0u) { if (xb_ld(&(bar)[XB_TMO])) break; if (_sp > XB_SPIN_CAP) { atomicAdd(&(bar)[XB_TMO], 1u); break; } } } } while (0)

struct XcdBarrier {
    unsigned* bar; unsigned x;
    volatile LAS unsigned* st;
};

__device__ __forceinline__ XcdBarrier xcd_barrier_post(unsigned* bar, volatile LAS unsigned* st) {
    XcdBarrier b; b.bar = bar; b.x = xb_xcc_id(); b.st = st;
    if (threadIdx.x == 0) (void)xb_add(&bar[XB_XCNT(b.x)], 1u);
    return b;
}
__device__ __forceinline__ void xcd_barrier_complete(unsigned* bar, unsigned x, unsigned& nloc, unsigned& nx) {
    const unsigned G = gridDim.x * gridDim.y * gridDim.z;
    unsigned sum, cnt, mine, sp = 0u;
    for (;;) {
        sum = 0u; cnt = 0u; mine = 0u;
#pragma unroll
        for (unsigned j = 0; j < 16; ++j) { const unsigned c = xb_ld(&bar[XB_XCNT(j)]); sum += c; cnt += (c > 0u) ? 1u : 0u; mine = (j == x) ? c : mine; }
        if (sum == G) break;
        __builtin_amdgcn_s_sleep(1);
        if ((++sp & 255u) == 0u) { if (xb_ld(&bar[XB_TMO])) break; if (sp > XB_SPIN_CAP) { atomicAdd(&bar[XB_TMO], 1u); break; } }
    }
    nloc = mine > 0u ? mine : 1u; nx = cnt > 0u ? cnt : 1u;
}

__device__ __forceinline__ void xcd_barrier(const XcdBarrier& b) {
    asm volatile("s_waitcnt vmcnt(0)" ::: "memory");
    __syncthreads();
    if (threadIdx.x == 0) {
        unsigned* bar = b.bar;
        __builtin_amdgcn_s_waitcnt(0);
        unsigned nloc = b.st[0], nx = b.st[1];
        if (nloc == 0u) { xcd_barrier_complete(bar, b.x, nloc, nx); b.st[0] = nloc; b.st[1] = nx; }
        const unsigned old = xb_add(&bar[XB_XSUB(b.x)], 1u);
        const unsigned gen = old / nloc;
        if (old + 1u == (gen + 1u) * nloc) {
            __builtin_amdgcn_fence(__ATOMIC_RELEASE, "agent");
            asm volatile("s_waitcnt vmcnt(0)" ::: "memory");
            const unsigned og = xb_add(&bar[XB_TOP], 1u);
            const unsigned tg = og / nx;
            if (og + 1u == (tg + 1u) * nx) xb_add(&bar[XB_TOPGEN], 1u);
            else XB_SPIN(xb_ld(&bar[XB_TOPGEN]) == tg, bar);
            __builtin_amdgcn_fence(__ATOMIC_ACQUIRE, "agent");
            xb_add(&bar[XB_XGEN(b.x)], 1u);
            asm volatile("s_waitcnt vmcnt(0)" ::: "memory");
        } else {
            XB_SPIN(xb_ld(&bar[XB_XGEN(b.x)]) == gen, bar);
            __builtin_amdgcn_fence(__ATOMIC_ACQUIRE, "agent");
            asm volatile("s_waitcnt vmcnt(0)" ::: "memory");
        }
    }
    __syncthreads();
}


__device__ __forceinline__ void grid_bar(unsigned* ctr, unsigned target) {
    asm volatile("s_waitcnt vmcnt(0)" ::: "memory");
    __syncthreads();
    if (threadIdx.x == 0) {
        __builtin_amdgcn_fence(__ATOMIC_RELEASE, "agent");
        asm volatile("s_waitcnt vmcnt(0)" ::: "memory");
        __hip_atomic_fetch_add(ctr, 1u, __ATOMIC_RELAXED, __HIP_MEMORY_SCOPE_AGENT);
        while (__hip_atomic_load(ctr, __ATOMIC_RELAXED, __HIP_MEMORY_SCOPE_AGENT) < target) __builtin_amdgcn_s_sleep(1);
        __builtin_amdgcn_fence(__ATOMIC_ACQUIRE, "agent");
        asm volatile("s_waitcnt vmcnt(0)" ::: "memory");
    }
    __syncthreads();
}

namespace pg8 {
constexpr int BM = 256, BK = 64, HALF = 128, HTB = HALF * BK * 2, STAGE_BYTES = 8 * HTB, NXCD = 8, WGM = 8;
__host__ __device__ __forceinline__ int lds_byte(int r, int c) { const int st = (r >> 4) * 2 + (c >> 5), rr = r & 15, cc = c & 31, ob = rr * 64 + cc * 2; return st * 1024 + (ob ^ (((ob >> 9) & 1) << 5)); }
__host__ __device__ __forceinline__ void stage_rc(int b, int& R, int& C) { const int st = b / 1024, sb = b % 1024, swz = sb ^ (((sb >> 9) & 1) << 5); R = (st >> 1) * 16 + swz / 64; C = (st & 1) * 32 + (swz % 64) / 2; }
__host__ __device__ __forceinline__ int perm32(int rho) { const int n = rho >> 4, i = rho & 15; return 8 * (i >> 2) + 4 * n + (i & 3); }
struct Unit { int pm, pn, koff, hs; };
struct Gemm { const f16* A; const f16* Bt; int lda, ldb, nt; };
struct StaticOrder {
    int nM, nN, nwg, G, c, lru, hm;
    __device__ void init(int M, int N, int G_, int c_, int lru_, int hm_) { hm = hm_; nM = (hm ? 2 : 1) * M / BM; nN = N / BM; nwg = nM * nN; G = G_; c = c_; lru = lru_; }
    __device__ bool next(int i, Unit& u) const {
        const long L = (long)i * G + c; if (L >= nwg) return false;
        int wgid = (int)L; { const int q = nwg / NXCD, r = nwg % NXCD, xcd = wgid % NXCD, off = wgid / NXCD; wgid = (xcd < r ? xcd * (q + 1) : r * (q + 1) + (xcd - r) * q) + off; }
        const int nig = WGM * nN, gid = wgid / nig, fm = gid * WGM, gsz = (nM - fm) < WGM ? (nM - fm) : WGM;
        u.pm = fm + ((wgid % nig) % gsz); u.pn = (wgid % nig) / gsz; u.koff = 0; u.hs = 2;
        if (hm) { u.hs = u.pm & 1; u.pm >>= 1; }
        if (lru) { const int j = u.pn; u.koff = j == 0 ? 0 : j == 1 ? 64 : j == 2 ? 192 : j == 3 ? 320 : j == 4 ? 448 : j == 5 ? 640 : j == 6 ? 704 : j == 7 ? 832 : j == 8 ? 960 : 1024; }
        return true;
    }
};
template <class EpiD>
__device__ __forceinline__ void gemm_phase(LAS unsigned char* lds, const Gemm g, const StaticOrder& S, const EpiD& ED) {
    const int tid = otid(), wid = __builtin_amdgcn_readfirstlane(tid >> 6), lane = tid & 63, wr = wid >> 2, wc = wid & 3, fr = lane & 15, fq = lane >> 4;
    const int nt = g.nt;
    unsigned voffA[2], voffB[2];
#pragma unroll
    for (int i = 0; i < 2; ++i) { int R, C; stage_rc(tid * 16 + i * 8192, R, C); const int Rb = (R & ~31) + perm32(R & 31);
        voffA[i] = (unsigned)(R * g.lda + C) * 2u; voffB[i] = (unsigned)(Rb * g.ldb + C) * 2u; }
    const size_t kstep = (size_t)(BK * 2);
    const size_t hstepA = (size_t)HALF * g.lda * 2, hstepB = (size_t)HALF * g.ldb * 2;
    const unsigned ldsw = (unsigned)wid * 1024u;
    const int aoff = lds_byte(wr * 64 + fr, fq * 8), boff = lds_byte(wc * 32 + fr, fq * 8);
#define PG8_SA(b, h) (((b) * 2 + (h)) * HTB)
#define PG8_SB(b, h) ((4 + (b) * 2 + (h)) * HTB)
#define PG8_STAGE(bufoff, gbase, voff) do { _Pragma("unroll") for (int _i = 0; _i < 2; ++_i) \
        __builtin_amdgcn_global_load_lds((const unsigned*)((const char*)(gbase) + (voff)[_i]), (LAS unsigned*)(lds + (bufoff) + ldsw + _i * 8192), 16, 0, 0); } while (0)
#define PG8_LDA(dst, b, h) do { _Pragma("unroll") for (int m = 0; m < 4; ++m) _Pragma("unroll") for (int k = 0; k < 2; ++k) dst[m][k] = *(const LAS f16x8*)(lds + PG8_SA(b, h) + aoff + m * 2048 + k * 1024); } while (0)
#define PG8_LDB(dst, b, h) do { _Pragma("unroll") for (int n = 0; n < 2; ++n) _Pragma("unroll") for (int k = 0; k < 2; ++k) dst[n][k] = *(const LAS f16x8*)(lds + PG8_SB(b, h) + boff + n * 2048 + k * 1024); } while (0)
#define PG8_MMA(ai, bj, At, Bt) do { __builtin_amdgcn_s_setprio(1); _Pragma("unroll") for (int m = 0; m < 4; ++m) _Pragma("unroll") for (int n = 0; n < 2; ++n) _Pragma("unroll") for (int k = 0; k < 2; ++k) \
        acc[ai][bj][m][n] = __builtin_amdgcn_mfma_f32_16x16x32_f16(Bt[n][k], At[m][k], acc[ai][bj][m][n], 0, 0, 0); __builtin_amdgcn_s_setprio(0); } while (0)
#define PG8_WAIT_V(n) asm volatile("s_waitcnt vmcnt(" #n ")" ::: "memory")
#define PG8_WAIT_L(n) asm volatile("s_waitcnt lgkmcnt(" #n ")" ::: "memory")
#define PG8_BAR __builtin_amdgcn_s_barrier()
#define PG8_SCHED __builtin_amdgcn_sched_barrier(0)
    Unit cur, nxt; int ui = 0;
    if (!S.next(0, cur)) return;
    f32x4 acc[2][2][4][2];
#pragma unroll
    for (int a = 0; a < 2; ++a)
#pragma unroll
        for (int b = 0; b < 2; ++b)
#pragma unroll
            for (int m = 0; m < 4; ++m)
#pragma unroll
                for (int n = 0; n < 2; ++n) acc[a][b][m][n] = (f32x4){0.f, 0.f, 0.f, 0.f};
    f16x8 At[4][2], B0[2][2], B1[2][2];
    const char* cA = (const char*)g.A + (size_t)cur.pm * 2 * hstepA + (size_t)cur.koff * 2; const char* cB = (const char*)g.Bt + (size_t)cur.pn * 2 * hstepB + (size_t)cur.koff * 2;
    PG8_STAGE(PG8_SB(0, 0), cB, voffB); PG8_STAGE(PG8_SB(0, 1), cB + hstepB, voffB); PG8_STAGE(PG8_SA(0, 0), cA, voffA); PG8_STAGE(PG8_SA(0, 1), cA + hstepA, voffA);
    if (wr == 1) PG8_BAR;
    PG8_WAIT_V(2); PG8_BAR;
    PG8_STAGE(PG8_SB(1, 0), cB + kstep, voffB); PG8_STAGE(PG8_SA(1, 0), cA + kstep, voffA); PG8_STAGE(PG8_SB(1, 1), cB + hstepB + kstep, voffB);
    PG8_WAIT_V(6); PG8_BAR;
    for (;;) {
        const bool has_next = S.next(ui + 1, nxt);
        const char* nA = has_next ? (const char*)g.A + (size_t)nxt.pm * 2 * hstepA + (size_t)nxt.koff * 2 : cA; const char* nB = has_next ? (const char*)g.Bt + (size_t)nxt.pn * 2 * hstepB + (size_t)nxt.koff * 2 : cB;
        for (int t = 0; t < nt; t += 2) {
            const bool last = (t == nt - 2);
            const char* a1 = cA + (size_t)(t + 1) * kstep;
            const char* a2 = last ? nA : cA + (size_t)(t + 2) * kstep; const char* b2 = last ? nB : cB + (size_t)(t + 2) * kstep;
            const char* a3 = a2 + kstep; const char* b3 = b2 + kstep;
            PG8_LDB(B0, 0, 0); PG8_LDB(B1, 0, 1); PG8_SCHED; PG8_LDA(At, 0, 0); PG8_STAGE(PG8_SA(1, 1), a1 + hstepA, voffA);
            PG8_WAIT_V(8); PG8_WAIT_L(0); PG8_BAR; if (cur.hs != 1) { PG8_MMA(0, 0, At, B0); PG8_MMA(0, 1, At, B1); } PG8_BAR; PG8_SCHED;
            PG8_LDA(At, 0, 1); PG8_STAGE(PG8_SB(0, 0), b2, voffB); PG8_STAGE(PG8_SB(0, 1), b2 + hstepB, voffB); PG8_STAGE(PG8_SA(0, 0), a2, voffA);
            PG8_WAIT_V(8); PG8_WAIT_L(0); PG8_BAR; if (cur.hs != 0) { PG8_MMA(1, 0, At, B0); PG8_MMA(1, 1, At, B1); } PG8_BAR; PG8_SCHED;
            PG8_LDB(B0, 1, 0); PG8_LDB(B1, 1, 1); PG8_SCHED; PG8_LDA(At, 1, 0); PG8_STAGE(PG8_SA(0, 1), a2 + hstepA, voffA);
            PG8_WAIT_V(8); PG8_WAIT_L(0); PG8_BAR; if (cur.hs != 1) { PG8_MMA(0, 0, At, B0); PG8_MMA(0, 1, At, B1); } PG8_BAR; PG8_SCHED;
            PG8_LDA(At, 1, 1); PG8_STAGE(PG8_SB(1, 0), b3, voffB); PG8_STAGE(PG8_SB(1, 1), b3 + hstepB, voffB); PG8_STAGE(PG8_SA(1, 0), a3, voffA);
            PG8_WAIT_V(8); PG8_WAIT_L(0); PG8_BAR; if (cur.hs != 0) { PG8_MMA(1, 0, At, B0); PG8_MMA(1, 1, At, B1); } PG8_BAR; PG8_SCHED;
        }
        if (wr == 0) PG8_BAR;
        ED(acc, cur, wr, wc, fr, fq);
        if (!has_next) break;
#pragma unroll
        for (int a = 0; a < 2; ++a)
#pragma unroll
            for (int b = 0; b < 2; ++b)
#pragma unroll
                for (int m = 0; m < 4; ++m)
#pragma unroll
                    for (int n = 0; n < 2; ++n) acc[a][b][m][n] = (f32x4){0.f, 0.f, 0.f, 0.f};
        cur = nxt; cA = nA; cB = nB; ++ui;
        if (wr == 1) PG8_BAR;
    }
    PG8_WAIT_V(0);
    PG8_BAR;
#undef PG8_SA
#undef PG8_SB
#undef PG8_STAGE
#undef PG8_LDA
#undef PG8_LDB
#undef PG8_MMA
#undef PG8_WAIT_V
#undef PG8_WAIT_L
#undef PG8_BAR
#undef PG8_SCHED
}
}

__device__ __forceinline__ void st8(f16* p, const f32x4& a, const f32x4& b) {
    f16x8 v; v[0] = (f16)a[0]; v[1] = (f16)a[1]; v[2] = (f16)a[2]; v[3] = (f16)a[3]; v[4] = (f16)b[0]; v[5] = (f16)b[1]; v[6] = (f16)b[2]; v[7] = (f16)b[3];
    *(f16x8*)p = v;
}
__device__ __forceinline__ void ld8f(const f16* p, float* o) { const f16x8 v = *(const f16x8*)p;
#pragma unroll
    for (int i = 0; i < 8; ++i) o[i] = (float)v[i]; }
__device__ __forceinline__ void ld8g(const float* p, float* o) { const f32x4 a = *(const f32x4*)p, b = *(const f32x4*)(p + 4); o[0] = a[0]; o[1] = a[1]; o[2] = a[2]; o[3] = a[3]; o[4] = b[0]; o[5] = b[1]; o[6] = b[2]; o[7] = b[3]; }

struct EpiProj {
    unsigned char* ws;
    __device__ __forceinline__ void operator()(int row, int pn, int cin, const f32x4& a0, const f32x4& a1, const f32x4& b0, const f32x4& b1) const {
        size_t off; int ld, ct;
        if (pn < 10) { off = OFF_LRUXY; ld = 2560; ct = pn; } else if (pn < 22) { off = OFF_RKV; ld = 3072; ct = pn - 10; } else if (pn < 24) { off = OFF_LORAR; ld = 512; ct = pn - 22; }
        else if (pn < 28) { off = OFF_Q; ld = 1024; ct = pn - 24; } else if (pn < 30) { off = OFF_KVRAW; ld = 512; ct = pn - 28; } else if (pn < 42) { off = OFF_GATES; ld = 3072; ct = pn - 30; }
        else { off = OFF_V1O; ld = 256; ct = 0; }
        f16* p = (f16*)(ws + off) + (size_t)row * ld + ct * 256 + cin;
        st8(p, a0, a1); st8(p + 128, b0, b1);
    }
};
struct EpiLruGate {
    const f16* xa; f16* loga; f16* u; const float* ba; const float* bx; const float* lam;
    __device__ __forceinline__ void operator()(int row, int pn, int cin, const f32x4& a0, const f32x4& a1, const f32x4& b0, const f32x4& b1) const {
        const int c0 = pn * 128 + cin; float xv[8], bav[8], bxv[8], lv[8];
        ld8f(xa + (size_t)row * LRUW + c0, xv); ld8g(ba + c0, bav); ld8g(bx + c0, bxv); ld8g(lam + c0, lv);
        f16x8 ol, ou;
#pragma unroll
        for (int e = 0; e < 8; ++e) {
            const float pa = (e < 4 ? a0[e & 3] : a1[e & 3]) + bav[e], px = (e < 4 ? b0[e & 3] : b1[e & 3]) + bxv[e];
            const float la = -8.f * sigm(pa) * lv[e];
            const float z = 2.f * la;
            const float em = z > -0.5f ? -z * (1.f + z * (0.5f + z * (0.16666667f + z * (0.041666668f + z * 0.0083333338f)))) : 1.f - __expf(z);
            const float mult = sqrtf(fmaxf(em, 0.f));
            ol[e] = (f16)la; ou[e] = (f16)(xv[e] * sigm(px) * mult);
        }
        *(f16x8*)(loga + (size_t)row * LRUW + c0) = ol; *(f16x8*)(u + (size_t)row * LRUW + c0) = ou;
    }
};
template <int MODE> struct EpiLora {
    f16* O; const float* bias;
    __device__ __forceinline__ void operator()(int row, int pn, int cin, const f32x4& a0, const f32x4& a1, const f32x4& b0, const f32x4& b1) const {
#pragma unroll
        for (int bj = 0; bj < 2; ++bj) {
            const int c0 = pn * 256 + bj * 128 + cin; float bv[8];
            if (MODE != 2) ld8g(bias + c0, bv);
            f16x8 o;
#pragma unroll
            for (int e = 0; e < 8; ++e) {
                const float v = bj == 0 ? (e < 4 ? a0[e & 3] : a1[e & 3]) : (e < 4 ? b0[e & 3] : b1[e & 3]);
                float r;
                if (MODE == 0) { const float z = bv[e] + v; const float sp = (z > 15.f) ? __expf(-z) : __logf(1.f + __expf(-z)); const float w = -sp - 0.5f; r = -__expf(w); }
                else if (MODE == 1) r = sigm(bv[e] + v);
                else r = v;
                o[e] = (f16)r;
            }
            *(f16x8*)(O + (size_t)row * 1024 + c0) = o;
        }
    }
};
template <int BR> struct EpiMerge {
    const f16* gates; float* merged; f16* mixed;
    __device__ __forceinline__ void operator()(int row, int pn, int cin, const f32x4& a0, const f32x4& a1, const f32x4& b0, const f32x4& b1) const {
#pragma unroll
        for (int bj = 0; bj < 2; ++bj) {
            const int c0 = pn * 256 + bj * 128 + cin; float gv[8], mv[8];
            ld8f(gates + (size_t)row * 3072 + BR * 1024 + c0, gv);
            float* mp = merged + (size_t)row * 1024 + c0;
            if (BR > 0) ld8g(mp, mv);
            float o[8];
#pragma unroll
            for (int e = 0; e < 8; ++e) {
                const float v = bj == 0 ? (e < 4 ? a0[e & 3] : a1[e & 3]) : (e < 4 ? b0[e & 3] : b1[e & 3]);
                o[e] = (BR > 0 ? mv[e] : 0.f) + sigm(gv[e]) * v;
            }
            if (BR < 2) { *(f32x4*)mp = (f32x4){o[0], o[1], o[2], o[3]}; *(f32x4*)(mp + 4) = (f32x4){o[4], o[5], o[6], o[7]}; }
            else { f16x8 h;
#pragma unroll
                for (int e = 0; e < 8; ++e) h[e] = (f16)o[e];
                *(f16x8*)(mixed + (size_t)row * 1024 + c0) = h; }
        }
    }
};
struct EpiResid {
    const float* xin; float* out; const float* gate  ; int seg;
    __device__ __forceinline__ void operator()(int row, int pn, int cin, const f32x4& a0, const f32x4& a1, const f32x4& b0, const f32x4& b1) const {
        const size_t g = (size_t)grow(row, seg); const int b = row >> 11;
#pragma unroll
        for (int bj = 0; bj < 2; ++bj) {
            const int c0 = pn * 256 + bj * 128 + cin; float xv[8], gv[8];
            ld8g(xin + g * 1024 + c0, xv); ld8g(gate + b * 6144 + c0, gv);
            float o[8];
#pragma unroll
            for (int e = 0; e < 8; ++e) { const float v = bj == 0 ? (e < 4 ? a0[e & 3] : a1[e & 3]) : (e < 4 ? b0[e & 3] : b1[e & 3]); o[e] = xv[e] + gv[e] * v; }
            float* op = out + g * 1024 + c0;
            *(f32x4*)op = (f32x4){o[0], o[1], o[2], o[3]}; *(f32x4*)(op + 4) = (f32x4){o[4], o[5], o[6], o[7]};
        }
    }
};
struct EpiSwiglu {
    f16* ffh;
    __device__ __forceinline__ void operator()(int row, int pn, int cin, const f32x4& a0, const f32x4& a1, const f32x4& b0, const f32x4& b1) const {
        f16x8 o;
#pragma unroll
        for (int e = 0; e < 8; ++e) { const float gt = e < 4 ? a0[e & 3] : a1[e & 3], up = e < 4 ? b0[e & 3] : b1[e & 3]; o[e] = (f16)(gt * sigm(gt) * up); }
        *(f16x8*)(ffh + (size_t)row * DFF + pn * 128 + cin) = o;
    }
};
struct EpiDispatch {
    int kind; const Params& P; int l, seg;
    template <class E> __device__ __forceinline__ void run(const E& e, const f32x4 (&acc)[2][2][4][2], const pg8::Unit& u, int wr, int wc, int fr, int fq) const {
#pragma unroll
        for (int ai = 0; ai < 2; ++ai) { if (u.hs == 1 - ai) continue;
#pragma unroll
            for (int m = 0; m < 4; ++m) {
                const int row = u.pm * 256 + ai * 128 + wr * 64 + m * 16 + fr;
                __builtin_amdgcn_sched_barrier(0);
                e(row, u.pn, wc * 32 + 8 * fq, acc[ai][0][m][0], acc[ai][0][m][1], acc[ai][1][m][0], acc[ai][1][m][1]);
            } }
    }
    __device__ __forceinline__ void operator()(const f32x4 (&acc)[2][2][4][2], const pg8::Unit& u, int wr, int wc, int fr, int fq) const {
        unsigned char* ws = ows(P.ws); const float* const* in = P.in; float* out = P.out; const float* xin = l == 0 ? P.in[I_X] : P.out; const float* mod = (const float*)(ws + OFF_MOD) + (size_t)l * 4 * 6144;
        const f16* gates = (const f16*)(ws + OFF_GATES); float* merged = (float*)(ws + OFF_MERGED); f16* mixed = (f16*)(ws + OFF_MIXED);
        switch (kind) {
        case 0: if (EPON(0)) run(EpiProj{ws}, acc, u, wr, wc, fr, fq); break;
        case 1: if (EPON(1)) run(EpiLruGate{(const f16*)(ws + OFF_XA), (f16*)(ws + OFF_LOGA), (f16*)(ws + OFF_U), in[I_LRUBA] + l * 1280, in[I_LRUBX] + l * 1280, (const float*)(ws + OFF_SP) + l * 1280}, acc, u, wr, wc, fr, fq); break;
        case 2: if (EPON(2)) run(EpiLora<0>{(f16*)(ws + OFF_LD), in[I_W0] + l * 1024}, acc, u, wr, wc, fr, fq); break;
        case 3: if (EPON(3)) run(EpiLora<1>{(f16*)(ws + OFF_A), in[I_A0] + l * 1024}, acc, u, wr, wc, fr, fq); break;
        case 4: if (EPON(4)) run(EpiLora<2>{(f16*)(ws + OFF_G), nullptr}, acc, u, wr, wc, fr, fq); break;
        case 5: if (EPON(5)) run(EpiLora<1>{(f16*)(ws + OFF_VMIX), in[I_V0]}, acc, u, wr, wc, fr, fq); break;
        case 6: if (EPON(6)) run(EpiMerge<0>{gates, merged, mixed}, acc, u, wr, wc, fr, fq); break;
        case 7: if (EPON(7)) run(EpiMerge<1>{gates, merged, mixed}, acc, u, wr, wc, fr, fq); break;
        case 8: if (EPON(8)) run(EpiMerge<2>{gates, merged, mixed}, acc, u, wr, wc, fr, fq); break;
        case 9: if (EPON(9)) run(EpiResid{xin, out, mod + 2048, seg}, acc, u, wr, wc, fr, fq); break;
        case 10: if (EPON(10)) run(EpiSwiglu{(f16*)(ws + OFF_FFH)}, acc, u, wr, wc, fr, fq); break;
        default: if (EPON(11)) run(EpiResid{out, out, mod + 5120, seg}, acc, u, wr, wc, fr, fq); break;
        }
    }
};

template <class Src> __device__ __forceinline__ void prep_w(f16* Wt, int N, int K, const Src& src, float* tile) {
    const int tid = otid();
    if ((K & 255) == 0) {
        const int nkt = K / 256, ntile = (N / 64) * nkt;
        for (int t = blockIdx.x; t < ntile; t += gridDim.x) {
            const int n0 = (t / nkt) * 64, k0 = (t % nkt) * 256;
            float v[32];
#pragma unroll
            for (int i = 0; i < 32; ++i) v[i] = src(n0 + (tid & 63), k0 + (tid >> 6) + 8 * i);
#pragma unroll
            for (int i = 0; i < 32; ++i) tile[((tid >> 6) + 8 * i) * 65 + (tid & 63)] = v[i];
            __syncthreads();
#pragma unroll
            for (int i = 0; i < 8; ++i) { const int nn = (tid >> 6) + 8 * i;
#pragma unroll
                for (int j = 0; j < 4; ++j) { const int kk = (tid & 63) + 64 * j; Wt[(size_t)(n0 + nn) * K + k0 + kk] = (f16)tile[kk * 65 + nn]; } }
            __syncthreads();
        }
        return;
    }
    const int nkt = K / 64, ntile = (N / 64) * nkt;
    for (int t = blockIdx.x; t < ntile; t += gridDim.x) {
        const int n0 = (t / nkt) * 64, k0 = (t % nkt) * 64;
#pragma unroll
        for (int i = 0; i < 8; ++i) { const int kk = (tid >> 6) + 8 * i, nn = tid & 63; tile[kk * 65 + nn] = src(n0 + nn, k0 + kk); }
        __syncthreads();
#pragma unroll
        for (int i = 0; i < 8; ++i) { const int nn = (tid >> 6) + 8 * i, kk = tid & 63; Wt[(size_t)(n0 + nn) * K + k0 + kk] = (f16)tile[kk * 65 + nn]; }
        __syncthreads();
    }
}

__device__ __forceinline__ void phase_prep(const Params& P, int l, float* tile) {
    f16* W = (f16*)(P.ws + OFF_W);
    { const float* w = P.in[I_WIN] + (size_t)l * 1024 * INC; const float* v1 = P.in[I_V1];
      prep_w(W + W_IN, l == 0 ? 10752 : NIN, 1024, [=](int n, int k) -> float {
          int s;
          if (n < 5632) s = n;
          else if (n < 6144) { const int j = n - 5632; s = j < 64 ? 5632 + j : (j >= 128 && j < 192) ? 5696 + (j - 128) : (j >= 256 && j < 416) ? 5760 + (j - 256) : -1; }
          else if (n < 7168) s = 5920 + (n - 6144);
          else if (n < 7680) s = 6944 + (n - 7168);
          else if (n < 10752) s = 7456 + (n - 7680);
          else { const int j = n - 10752; return j < 32 ? v1[(size_t)k * 32 + j] : 0.f; }
          return s < 0 ? 0.f : w[(size_t)k * INC + s]; }, tile); }
    { const float* wa = P.in[I_LRUWA] + (size_t)l * 16 * 6400; const float* wx = P.in[I_LRUWX] + (size_t)l * 16 * 6400;
      prep_w(W + W_LG, 2560, 1280, [=](int n, int k) -> float {
          const int half = (n & 255) >> 7, c = (n >> 8) * 128 + (n & 127), nb = c / 80, jj = c - nb * 80, kb = k / 80, ii = k - kb * 80;
          if (kb != nb) return 0.f;
          return (half ? wx : wa)[(size_t)(nb * 80 + ii) * 80 + jj]; }, tile); }
    { const float* w = P.in[I_WLRUO] + (size_t)l * 1280 * 1024; prep_w(W + W_LO, 1024, 1280, [=](int n, int k) -> float { return w[(size_t)k * 1024 + n]; }, tile); }
    { const float* w = P.in[I_WRWO] + (size_t)l * 1024 * 1024; prep_w(W + W_RO, 1024, 1024, [=](int n, int k) -> float { return w[(size_t)k * 1024 + n]; }, tile); }
    { const float* w = P.in[I_WATTO] + (size_t)l * 1024 * 1024; prep_w(W + W_AO, 1024, 1024, [=](int n, int k) -> float { return w[(size_t)k * 1024 + n]; }, tile); }
    { const float* w = P.in[I_WOUT] + (size_t)l * 1024 * 1024; prep_w(W + W_OUT, 1024, 1024, [=](int n, int k) -> float { return w[(size_t)k * 1024 + n]; }, tile); }
    { const float* w = P.in[I_WFI] + (size_t)l * 1024 * 5632;
      prep_w(W + W_FI, 5632, 1024, [=](int n, int k) -> float { const int half = (n & 255) >> 7, idx = (n >> 8) * 128 + (n & 127); return w[(size_t)k * 5632 + half * 2816 + idx]; }, tile); }
    { const float* w = P.in[I_WFO] + (size_t)l * 2816 * 1024; prep_w(W + W_FO, 1024, 2816, [=](int n, int k) -> float { return w[(size_t)k * 1024 + n]; }, tile); }
    { const float* w = P.in[I_W2] + (size_t)l * 64 * 1024; prep_w(W + W_W2, 1024, 128, [=](int n, int k) -> float { return k < 64 ? w[(size_t)k * 1024 + n] : 0.f; }, tile); }
    { const float* w = P.in[I_A2] + (size_t)l * 64 * 1024; prep_w(W + W_A2, 1024, 128, [=](int n, int k) -> float { return k < 64 ? w[(size_t)k * 1024 + n] : 0.f; }, tile); }
    { const float* w = P.in[I_G2] + (size_t)l * 160 * 1024; prep_w(W + W_G2, 1024, 256, [=](int n, int k) -> float { return k < 160 ? w[(size_t)k * 1024 + n] : 0.f; }, tile); }
    if (l == 1) { const float* w = P.in[I_V2]; prep_w(W + W_V2, 1024, 128, [=](int n, int k) -> float { return k < 32 ? w[(size_t)k * 1024 + n] : 0.f; }, tile); }
}

__device__ __forceinline__ void phase_mod(const Params& P, float* lds) {
    const int tid = otid(), wave = tid >> 6, lane = tid & 63;
    float* sc = lds;
    float* red = lds + 4096;
    const float* c = P.in[I_C];
    for (int i = tid; i < 4096; i += NTHR) { const float v = c[i]; sc[i] = v * sigm(v); }
    __syncthreads();
    float* mod = (float*)(P.ws + OFF_MOD);
    if (blockIdx.x == 0) for (int i = tid; i < 2560; i += NTHR) ((float*)(P.ws + OFF_SP))[i] = log1pf(expf(-P.in[I_LAM][i]));
    for (int it = blockIdx.x; it < 192; it += gridDim.x) {
        const int l = it / 96, n = (it % 96) * 64 + lane;
        const float* w = P.in[I_WADA] + (size_t)l * 1024 * 6144 + n;
        float a0 = 0.f, a1 = 0.f, a2 = 0.f, a3 = 0.f;
        for (int k0 = wave * 128; k0 < wave * 128 + 128; k0 += 16) {
            float wv[16];
#pragma unroll
            for (int j = 0; j < 16; ++j) wv[j] = w[(size_t)(k0 + j) * 6144];
#pragma unroll
            for (int j = 0; j < 16; ++j) { const int k = k0 + j; a0 += sc[k] * wv[j]; a1 += sc[1024 + k] * wv[j]; a2 += sc[2048 + k] * wv[j]; a3 += sc[3072 + k] * wv[j]; }
        }
        red[(wave * 4 + 0) * 64 + lane] = a0; red[(wave * 4 + 1) * 64 + lane] = a1; red[(wave * 4 + 2) * 64 + lane] = a2; red[(wave * 4 + 3) * 64 + lane] = a3;
        __syncthreads();
        if (tid < 256) { const int b = tid >> 6; float s = P.in[I_BADA][l * 6144 + n];
#pragma unroll
            for (int w8 = 0; w8 < 8; ++w8) s += red[(w8 * 4 + b) * 64 + lane];
            mod[(size_t)(l * 4 + b) * 6144 + n] = s; }
        __syncthreads();
    }
}

__device__ __forceinline__ void phase_norm(const Params& P, const float* xin, int l, int seg, int which  , size_t hoff, int gw, int nw) {
    const int tid = otid(), lane = tid & 63;
    f16* H = (f16*)(ows(P.ws) + hoff);
    for (int r = gw; r < MS; r += nw) {
        const size_t g = (size_t)grow(r, seg); const int b = r >> 11;
        const float* mod = (const float*)(P.ws + OFF_MOD) + (size_t)(l * 4 + b) * 6144 + which * 3072;
        f32x4 v[4]; float ss = 0.f;
#pragma unroll
        for (int i = 0; i < 4; ++i) { v[i] = *(const f32x4*)(xin + g * 1024 + i * 256 + lane * 4); ss += v[i][0] * v[i][0] + v[i][1] * v[i][1] + v[i][2] * v[i][2] + v[i][3] * v[i][3]; }
        ss = wave_sum(ss);
        const float rs = rsqrtf(ss * (1.f / 1024.f) + 1e-6f);
#pragma unroll
        for (int i = 0; i < 4; ++i) { const int c = i * 256 + lane * 4; const f32x4 sh = *(const f32x4*)(mod + c), scl = *(const f32x4*)(mod + 1024 + c); f16x4 o;
#pragma unroll
            for (int e = 0; e < 4; ++e) o[e] = (f16)(v[i][e] * rs * (1.f + scl[e]) + sh[e]);
            *(f16x4*)(H + (size_t)r * 1024 + c) = o; }
    }
}

__device__ __forceinline__ void phase_elem(const Params& P, int l, int seg) {
    const int tid = otid(), lane = tid & 63, gt = blockIdx.x * NTHR + tid, ntot = gridDim.x * NTHR, gw = blockIdx.x * 8 + (tid >> 6), nw = gridDim.x * 8;
    unsigned char* ws = ows(P.ws);
    { const f16* X = (const f16*)(ws + OFF_LRUXY); f16* XA = (f16*)(ws + OFF_XA); f16* cw = (f16*)(ws + OFF_CONVC) + (size_t)(seg & 1) * 4 * 3 * 1280; const f16* cr = (const f16*)(ws + OFF_CONVC) + (size_t)((seg + 1) & 1) * 4 * 3 * 1280;
      const float* w = P.in[I_CONVW] + (size_t)l * 4 * 1280; const float* bia = P.in[I_CONVB] + (size_t)l * 1280;
      for (int it = gt; it < MS * 160; it += ntot) {
          const int r = it / 160, c0 = (it % 160) * 8, b = r >> 11, tl = r & 2047;
          float o[8]; ld8g(bia + c0, o);
#pragma unroll
          for (int j = 0; j < 4; ++j) {
              const int t2 = tl - 3 + j; float xv[8];
              if (t2 >= 0) ld8f(X + (size_t)(r - 3 + j) * 2560 + c0, xv);
              else if (seg > 0) ld8f(cr + (size_t)(b * 3 + (3 + t2)) * 1280 + c0, xv);
              else {
#pragma unroll
                  for (int e = 0; e < 8; ++e) xv[e] = 0.f; }
              float wv[8]; ld8g(w + j * 1280 + c0, wv);
#pragma unroll
              for (int e = 0; e < 8; ++e) o[e] += xv[e] * wv[e];
          }
          f16x8 h;
#pragma unroll
          for (int e = 0; e < 8; ++e) h[e] = (f16)o[e];
          *(f16x8*)(XA + (size_t)r * 1280 + c0) = h;
          if (tl >= SEGT - 3) *(f16x8*)(cw + (size_t)(b * 3 + (tl - (SEGT - 3))) * 1280 + c0) = *(const f16x8*)(X + (size_t)r * 2560 + c0);
      } }
    { const f16* X = (const f16*)(ws + OFF_LORAR); f16* AL = (f16*)(ws + OFF_ALORA); f16* cw = (f16*)(ws + OFF_LORAC) + (size_t)(seg & 1) * 4 * 512; const f16* cr = (const f16*)(ws + OFF_LORAC) + (size_t)((seg + 1) & 1) * 4 * 512;
      const float* mu = P.in[I_MU] + (size_t)l * RWC;
      for (int it = gt; it < MS * 64; it += ntot) {
          const int r = it >> 6, c0 = (it & 63) * 8, b = r >> 11, tl = r & 2047;
          const f16x8 raw = *(const f16x8*)(X + (size_t)r * 512 + c0);
          if (tl == SEGT - 1) *(f16x8*)(cw + b * 512 + c0) = raw;
          int mode, mo;
          if (c0 < 64) { mode = 0; mo = 3072 + c0; } else if (c0 >= 128 && c0 < 192) { mode = 1; mo = 3136 + (c0 - 128); } else if (c0 >= 256 && c0 < 416) { mode = 2; mo = 3200 + (c0 - 256); } else { mode = 3; mo = 0; }
          f16x8 o;
          if (mode == 3) {
#pragma unroll
              for (int e = 0; e < 8; ++e) o[e] = (f16)0.f;
          } else {
              float pv[8];
              if (tl > 0) ld8f(X + (size_t)(r - 1) * 512 + c0, pv);
              else if (seg > 0) ld8f(cr + b * 512 + c0, pv);
              else {
#pragma unroll
                  for (int e = 0; e < 8; ++e) pv[e] = 0.f; }
              float mv[8]; ld8g(mu + mo, mv);
#pragma unroll
              for (int e = 0; e < 8; ++e) { const float x = (float)raw[e]; const float p = x + (pv[e] - x) * mv[e]; o[e] = (f16)(mode == 0 ? tanhf(p) : mode == 1 ? p : sigm(p)); }
          }
          *(f16x8*)(AL + (size_t)r * 512 + c0) = o;
      } }
    { f16* Q = (f16*)(ws + OFF_Q); const f16* KV = (const f16*)(ws + OFF_KVRAW); f16* KN = (f16*)(ws + OFF_KN);
      const float* qg = P.in[I_QG] + l * 64; const float* kg = P.in[I_KG] + l * 64;
      for (int r = gw; r < MS; r += nw) {
          float v[16]; ld8f(Q + (size_t)r * 1024 + lane * 16, v); ld8f(Q + (size_t)r * 1024 + lane * 16 + 8, v + 8);
          float ss = 0.f;
#pragma unroll
          for (int e = 0; e < 16; ++e) ss += v[e] * v[e];
          ss += __shfl_xor(ss, 1); ss += __shfl_xor(ss, 2);
          const float rs = rsqrtf(ss * (1.f / 64.f) + 1e-6f) * 0.125f;
          float gv[16]; ld8g(qg + (lane & 3) * 16, gv); ld8g(qg + (lane & 3) * 16 + 8, gv + 8);
          f16x8 o0, o1;
#pragma unroll
          for (int e = 0; e < 8; ++e) { o0[e] = (f16)(v[e] * rs * gv[e]); o1[e] = (f16)(v[8 + e] * rs * gv[8 + e]); }
          *(f16x8*)(Q + (size_t)r * 1024 + lane * 16) = o0; *(f16x8*)(Q + (size_t)r * 1024 + lane * 16 + 8) = o1;
          const f16x4 kr = *(const f16x4*)(KV + (size_t)r * 512 + lane * 4);
          float kv[4] = {(float)kr[0], (float)kr[1], (float)kr[2], (float)kr[3]};
          float s2 = kv[0] * kv[0] + kv[1] * kv[1] + kv[2] * kv[2] + kv[3] * kv[3];
          s2 += __shfl_xor(s2, 1); s2 += __shfl_xor(s2, 2); s2 += __shfl_xor(s2, 4); s2 += __shfl_xor(s2, 8);
          const float rk = rsqrtf(s2 * (1.f / 64.f) + 1e-6f);
          const f32x4 kgv = *(const f32x4*)(kg + (lane & 15) * 4);
          f16x4 ko; ko[0] = (f16)(kv[0] * rk * kgv[0]); ko[1] = (f16)(kv[1] * rk * kgv[1]); ko[2] = (f16)(kv[2] * rk * kgv[2]); ko[3] = (f16)(kv[3] * rk * kgv[3]);
          *(f16x4*)(KN + (size_t)grow(r, seg) * 256 + lane * 4) = ko;
      } }
    { const f16* KV = (const f16*)(ws + OFF_KVRAW); f16* VT = (f16*)(ws + OFF_VT);
      for (int it = gw; it < (MS / 64) * 4; it += nw) {
          const int tile = it >> 2, kvh = it & 3, r0 = tile * 64, b = r0 >> 11, pos0 = seg * SEGT + (r0 & 2047);
          f16x8 vv[8];
#pragma unroll
          for (int i = 0; i < 8; ++i)
#pragma unroll
              for (int e = 0; e < 8; ++e) vv[i][e] = KV[(size_t)(r0 + i * 8 + e) * 512 + 256 + kvh * 64 + lane];
          f16* dst = VT + ((size_t)((b * 4 + kvh) * 64 + lane)) * SEQ + pos0;
#pragma unroll
          for (int i = 0; i < 8; ++i) *(f16x8*)(dst + i * 8) = vv[i];
      } }
}

__device__ __forceinline__ void phase_rwprep(const Params& P, int l, int seg) {
    const int tid = otid(), lane = tid & 63, gw = blockIdx.x * 8 + (tid >> 6), nw = gridDim.x * 8;
    unsigned char* ws = ows(P.ws);
    const f16* __restrict__ X = (const f16*)(ws + OFF_RKV); const f16* __restrict__ A = (const f16*)(ws + OFF_A); const f16* __restrict__ VM = (const f16*)(ws + OFF_VMIX); f16* VF = (f16*)(ws + OFF_VFIRST);
    f16* __restrict__ R = (f16*)(ws + OFF_R); f16* __restrict__ K = (f16*)(ws + OFF_K); f16* __restrict__ V = (f16*)(ws + OFF_V); f16* __restrict__ KK = (f16*)(ws + OFF_KK);
    f16* __restrict__ cw = (f16*)(ws + OFF_RKVC) + (size_t)(seg & 1) * 4 * 3072; const f16* __restrict__ cr = (const f16*)(ws + OFF_RKVC) + (size_t)((seg + 1) & 1) * 4 * 3072;
    const float* mu = P.in[I_MU] + (size_t)l * RWC; const float* kkw = P.in[I_KK] + l * 1024; const float* kaw = P.in[I_KA] + l * 1024;
    const int half = gw & 1, c = half * 512 + lane * 8;
    float mur[8], muk[8], muv[8], kkv[8], kav[8];
    ld8g(mu + c, mur); ld8g(mu + 1024 + c, muk); ld8g(mu + 2048 + c, muv); ld8g(kkw + c, kkv); ld8g(kaw + c, kav);
    for (int r = gw >> 1; r < MS; r += nw >> 1) {
        const int b = r >> 11, tl = r & 2047; const size_t g = (size_t)grow(r, seg);
        const f16x8 r0 = *(const f16x8*)(X + (size_t)r * 3072 + c), k0 = *(const f16x8*)(X + (size_t)r * 3072 + 1024 + c), v0 = *(const f16x8*)(X + (size_t)r * 3072 + 2048 + c);
        f16x8 pr, pk, pv;
        if (tl > 0) { pr = *(const f16x8*)(X + (size_t)(r - 1) * 3072 + c); pk = *(const f16x8*)(X + (size_t)(r - 1) * 3072 + 1024 + c); pv = *(const f16x8*)(X + (size_t)(r - 1) * 3072 + 2048 + c); }
        else if (seg > 0) { pr = *(const f16x8*)(cr + b * 3072 + c); pk = *(const f16x8*)(cr + b * 3072 + 1024 + c); pv = *(const f16x8*)(cr + b * 3072 + 2048 + c); }
        else {
#pragma unroll
            for (int e = 0; e < 8; ++e) { pr[e] = (f16)0.f; pk[e] = (f16)0.f; pv[e] = (f16)0.f; } }
        const f16x8 a8 = *(const f16x8*)(A + (size_t)r * 1024 + c);
        f16x8 vf8, vm8;
        if (l == 1) { vf8 = *(const f16x8*)(VF + g * 1024 + c); vm8 = *(const f16x8*)(VM + (size_t)r * 1024 + c); }
        if (tl == SEGT - 1) { *(f16x8*)(cw + b * 3072 + c) = r0; *(f16x8*)(cw + b * 3072 + 1024 + c) = k0; *(f16x8*)(cw + b * 3072 + 2048 + c) = v0; }
        float xr[8], xk[8], xv[8], kk[8]; float ss = 0.f;
#pragma unroll
        for (int e = 0; e < 8; ++e) {
            const float rv = (float)r0[e], kv = (float)k0[e], vv = (float)v0[e];
            xr[e] = rv + ((float)pr[e] - rv) * mur[e]; xk[e] = kv + ((float)pk[e] - kv) * muk[e]; xv[e] = vv + ((float)pv[e] - vv) * muv[e];
            kk[e] = xk[e] * kkv[e]; ss += kk[e] * kk[e];
        }
        ss += __shfl_xor(ss, 1); ss += __shfl_xor(ss, 2); ss += __shfl_xor(ss, 4);
        const float rn = rsqrtf(fmaxf(ss, 1e-24f));
        f16x8 oR, oK, oV, oQ;
        if (l == 0) {
#pragma unroll
            for (int e = 0; e < 8; ++e) oV[e] = (f16)xv[e];
            *(f16x8*)(VF + g * 1024 + c) = oV;
        } else {
#pragma unroll
            for (int e = 0; e < 8; ++e) oV[e] = (f16)(xv[e] + ((float)vf8[e] - xv[e]) * (float)vm8[e]);
        }
#pragma unroll
        for (int e = 0; e < 8; ++e) { oR[e] = (f16)xr[e]; oK[e] = (f16)(xk[e] * (1.f + ((float)a8[e] - 1.f) * kav[e])); oQ[e] = (f16)(kk[e] * rn); }
        const size_t o = (size_t)r * 1024 + c;
        *(f16x8*)(R + o) = oR; *(f16x8*)(K + o) = oK; *(f16x8*)(V + o) = oV; *(f16x8*)(KK + o) = oQ;
    }
}

__device__ __forceinline__ void lru_wave(const Params& P, int seg, int fw, int nfw);
__device__ __forceinline__ void attention(const Params& P, int l, int seg, int gw, int nw, bool dry);
__device__ __forceinline__ unsigned lds_ld(LAS unsigned* p) { return __hip_atomic_load(p, __ATOMIC_ACQUIRE, __HIP_MEMORY_SCOPE_WORKGROUP); }
__device__ __forceinline__ void lds_inc(LAS unsigned* p) { __hip_atomic_fetch_add(p, 1u, __ATOMIC_RELEASE, __HIP_MEMORY_SCOPE_WORKGROUP); }
__device__ __forceinline__ void phase_rwscan(const Params& P, int l, int seg, float* lds, bool dry) {
    const int tid = otid(), lane = tid & 63, wave = tid >> 6;
    unsigned char* ws = ows(P.ws);
    constexpr int CH = 32, NCH = SEGT / CH, NBUF = 2;
    float* buf = lds;
    float* vbuf = lds + NBUF * 10240;
    float* yp = vbuf + NBUF * 512;
    LAS unsigned* flg = (LAS unsigned*)(yp + NBUF * 8192);
    if (tid < 8) flg[tid] = 0u;
    __syncthreads();
    if (wave >= 5) {
        const int fw = blockIdx.x * 3 + (wave - 5), nfw = gridDim.x * 3;
        lru_wave(P, seg, fw, nfw);
        attention(P, l, seg, fw, nfw, dry);
        if (seg + 1 < NSEG) phase_norm(P, l == 0 ? P.in[I_X] : P.out, l, seg + 1, 0, OFF_HN, fw, nfw);
        return;
    }
    int cbase = 0;
    for (int item = blockIdx.x; item < 256; item += gridDim.x, cbase += NCH) {
        const int b = item >> 6, h = (item >> 2) & 15, qd = item & 3;
        const size_t rowbase = (size_t)b * SEGT;
        if (wave < 4) {
            float* st = (float*)(ws + OFF_STATE) + ((size_t)item * 256 + tid) * 4;
            f32x2 S01 = (f32x2){0.f, 0.f}, S23 = S01;
            if (seg > 0) { const f32x4 s0 = *(const f32x4*)st; S01 = (f32x2){s0[0], s0[1]}; S23 = (f32x2){s0[2], s0[3]}; }
            const int ks = (lane & 15) * 4, rr = lane >> 4;
            for (int c = 0; c < NCH; ++c) {
                const int cg = cbase + c, p = cg & 1; const unsigned tgt = (unsigned)((cg >> 1) + 1);
                while (lds_ld(flg + p) < tgt) __builtin_amdgcn_s_sleep(1);
                LAS const float* bp = (LAS const float*)(buf + p * 10240 + ks); LAS const float* vp = (LAS const float*)(vbuf + p * 512 + wave * 4 + rr); LAS float* yo = (LAS float*)(yp + p * 8192 + wave * 64 + lane);
                asm volatile("" : "+v"(bp)); asm volatile("" : "+v"(vp)); asm volatile("" : "+v"(yo));
                f32x4 w4 = *(LAS const f32x4*)(bp), k4 = *(LAS const f32x4*)(bp + 2048), a4 = *(LAS const f32x4*)(bp + 4096), b4 = *(LAS const f32x4*)(bp + 6144), r4 = *(LAS const f32x4*)(bp + 8192);
                float v = vp[0];
                f32x4 nw4 = *(LAS const f32x4*)(bp + 64), nk4 = *(LAS const f32x4*)(bp + 2048 + 64), na4 = *(LAS const f32x4*)(bp + 4096 + 64), nb4 = *(LAS const f32x4*)(bp + 6144 + 64), nr4 = *(LAS const f32x4*)(bp + 8192 + 64);
                float nv = vp[16];
#pragma unroll 8
                for (int t = 0; t < CH; ++t) {
                    const int tn = t + 2 < CH ? t + 2 : CH - 1;
                    const f32x4 mw4 = *(LAS const f32x4*)(bp + tn * 64), mk4 = *(LAS const f32x4*)(bp + 2048 + tn * 64), ma4 = *(LAS const f32x4*)(bp + 4096 + tn * 64), mb4 = *(LAS const f32x4*)(bp + 6144 + tn * 64), mr4 = *(LAS const f32x4*)(bp + 8192 + tn * 64);
                    const float mv = vp[tn * 16];
                    float s0 = S01[0], s1 = S01[1], s2 = S23[0], s3 = S23[1];
                    float sa = __builtin_fmaf(s3, a4[3], __builtin_fmaf(s2, a4[2], __builtin_fmaf(s1, a4[1], s0 * a4[0])));
                    const float q0 = v * k4[0], q1 = v * k4[1], q2 = v * k4[2], q3 = v * k4[3];
                    sa = red16(sa);
                    s0 = __builtin_fmaf(s0, w4[0], __builtin_fmaf(sa, b4[0], q0)); s1 = __builtin_fmaf(s1, w4[1], __builtin_fmaf(sa, b4[1], q1));
                    s2 = __builtin_fmaf(s2, w4[2], __builtin_fmaf(sa, b4[2], q2)); s3 = __builtin_fmaf(s3, w4[3], __builtin_fmaf(sa, b4[3], q3));
                    yo[t * 256] = __builtin_fmaf(s3, r4[3], __builtin_fmaf(s2, r4[2], __builtin_fmaf(s1, r4[1], s0 * r4[0])));
                    asm volatile("" : "+v"(s0), "+v"(s1), "+v"(s2), "+v"(s3));
                    S01 = (f32x2){s0, s1}; S23 = (f32x2){s2, s3};
                    w4 = nw4; k4 = nk4; a4 = na4; b4 = nb4; r4 = nr4; v = nv;
                    nw4 = mw4; nk4 = mk4; na4 = ma4; nb4 = mb4; nr4 = mr4; nv = mv;
                }
                asm volatile("s_waitcnt lgkmcnt(0)" ::: "memory");
                if (lane == 0) lds_inc(flg + 4 + p);
            }
            if (!dry) *(f32x4*)st = (f32x4){S01[0], S01[1], S23[0], S23[1]};
        } else {
            const int lt = lane, tt = lt >> 3, c8 = (lt & 7) * 8;
            struct GS { f16x8 r[2], k[2], q[2], a[2], d[2]; f16x4 v; };
            GS g0, g1, g2;
            auto gload = [&](int hh, GS& g) {
#pragma unroll
                for (int hs = 0; hs < 2; ++hs) { const size_t o = (rowbase + hh * 16 + hs * 8 + tt) * 1024 + h * 64 + c8;
                    const unsigned char* wp = ws + o * 2; g.r[hs] = *(const f16x8*)(wp + OFF_R); g.k[hs] = *(const f16x8*)(wp + OFF_K); g.q[hs] = *(const f16x8*)(wp + OFF_KK); g.a[hs] = *(const f16x8*)(wp + OFF_A); g.d[hs] = *(const f16x8*)(wp + OFF_LD); }
                g.v = *(const f16x4*)((const f16*)(ws + OFF_V) + (rowbase + hh * 16 + (lt >> 2)) * 1024 + h * 64 + qd * 16 + (lt & 3) * 4);
            };
            auto lstore = [&](int p, int half, const GS& g) {
#pragma unroll
                for (int hs = 0; hs < 2; ++hs) { LAS float* bp = (LAS float*)(buf + p * 10240 + (half * 16 + hs * 8 + tt) * 64 + c8);
                    f32x4 o0, o1;
#pragma unroll
                    for (int e = 0; e < 4; ++e) { o0[e] = __expf((float)g.d[hs][e]); o1[e] = __expf((float)g.d[hs][4 + e]); }
                    *(LAS f32x4*)bp = o0; *(LAS f32x4*)(bp + 4) = o1;
#pragma unroll
                    for (int e = 0; e < 4; ++e) { o0[e] = (float)g.k[hs][e]; o1[e] = (float)g.k[hs][4 + e]; }
                    *(LAS f32x4*)(bp + 2048) = o0; *(LAS f32x4*)(bp + 2048 + 4) = o1;
#pragma unroll
                    for (int e = 0; e < 4; ++e) { o0[e] = -(float)g.q[hs][e]; o1[e] = -(float)g.q[hs][4 + e]; }
                    *(LAS f32x4*)(bp + 4096) = o0; *(LAS f32x4*)(bp + 4096 + 4) = o1;
#pragma unroll
                    for (int e = 0; e < 4; ++e) { o0[e] = (float)g.q[hs][e] * (float)g.a[hs][e]; o1[e] = (float)g.q[hs][4 + e] * (float)g.a[hs][4 + e]; }
                    *(LAS f32x4*)(bp + 6144) = o0; *(LAS f32x4*)(bp + 6144 + 4) = o1;
#pragma unroll
                    for (int e = 0; e < 4; ++e) { o0[e] = (float)g.r[hs][e]; o1[e] = (float)g.r[hs][4 + e]; }
                    *(LAS f32x4*)(bp + 8192) = o0; *(LAS f32x4*)(bp + 8192 + 4) = o1; }
                *(LAS f32x4*)(vbuf + p * 512 + (half * 16 + (lt >> 2)) * 16 + (lt & 3) * 4) = (f32x4){(float)g.v[0], (float)g.v[1], (float)g.v[2], (float)g.v[3]};
            };
            auto drain = [&](int c, int p, int half) {
#pragma unroll
                for (int i = 0; i < 4; ++i) {
                    const int o = lt + i * 64, tok = half * 16 + (o >> 4), ri = o & 15;
                    LAS const float* yy = (LAS const float*)(yp + p * 8192 + tok * 256 + (ri >> 2) * 64 + (ri & 3) * 16);
                    const f32x4 s0 = *(LAS const f32x4*)yy, s1 = *(LAS const f32x4*)(yy + 4), s2 = *(LAS const f32x4*)(yy + 8), s3 = *(LAS const f32x4*)(yy + 12);
                    const float sm = ((s0[0] + s0[1]) + (s0[2] + s0[3])) + ((s1[0] + s1[1]) + (s1[2] + s1[3])) + ((s2[0] + s2[1]) + (s2[2] + s2[3])) + ((s3[0] + s3[1]) + (s3[2] + s3[3]));
                    ((f16*)(ws + OFF_Y))[(rowbase + c * CH + tok) * 1024 + h * 64 + qd * 16 + ri] = (f16)sm;
                }
            };
            auto hstep = [&](int hh, const GS& gc, GS& gn) {
                const int c = hh >> 1, half = hh & 1, cg = cbase + c, p = cg & 1;
                if (hh + 2 < 2 * NCH) gload(hh + 2, gn);
                if (cg >= NBUF) {
                    if (half == 0) { const unsigned tgt = 4u * (unsigned)(cg >> 1); while (lds_ld(flg + 4 + p) < tgt) __builtin_amdgcn_s_sleep(1); }
                    if (c >= NBUF) drain(c - NBUF, p, half);
                }
                lstore(p, half, gc);
                if (half == 1) { asm volatile("s_waitcnt lgkmcnt(0)" ::: "memory"); if (lane == 0) lds_inc(flg + p); }
            };
            gload(0, g0); gload(1, g1);
            for (int hh = 0; hh < 2 * NCH - 2; hh += 3) { hstep(hh, g0, g2); hstep(hh + 1, g1, g0); hstep(hh + 2, g2, g1); }
            hstep(2 * NCH - 2, g0, g2); hstep(2 * NCH - 1, g1, g0);
            for (int c = NCH - NBUF; c < NCH; ++c) {
                const int cg = cbase + c, p = cg & 1; const unsigned tgt = 4u * (unsigned)((cg >> 1) + 1);
                while (lds_ld(flg + 4 + p) < tgt) __builtin_amdgcn_s_sleep(1);
                drain(c, p, 0); drain(c, p, 1);
            }
        }
    }
}


__device__ __forceinline__ void lru_agg(const Params& P, int gw, int nw) {
    const int tid = otid(), lane = tid & 63;
    unsigned char* ws = ows(P.ws);
    const f16* __restrict__ LA = (const f16*)(ws + OFF_LOGA); const f16* __restrict__ U = (const f16*)(ws + OFF_U); float* __restrict__ AG = (float*)(ws + OFF_AGG);
    for (int item = gw; item < 2560; item += nw) {
        const int ck = item & 31, g = (item >> 5) % 20, b = item / 640, c = g * 64 + lane;
        const size_t r0 = (size_t)b * SEGT + ck * 64;
        float L = 0.f, H = 0.f;
        for (int s0 = 0; s0 < 64; s0 += 16) {
            f16 la8[16], u8[16];
#pragma unroll
            for (int s = 0; s < 16; ++s) { la8[s] = LA[(r0 + s0 + s) * LRUW + c]; u8[s] = U[(r0 + s0 + s) * LRUW + c]; }
#pragma unroll
            for (int s = 0; s < 16; ++s) { const float la = (float)la8[s]; H = __expf(la) * H + (float)u8[s]; L += la; }
        }
        AG[((size_t)(b * 32 + ck) * 2) * LRUW + c] = L; AG[((size_t)(b * 32 + ck) * 2 + 1) * LRUW + c] = H;
    }
}
__device__ __forceinline__ void lru_wave(const Params& P, int seg, int fw, int nfw) {
    const int tid = otid(), lane = tid & 63;
    unsigned char* ws = ows(P.ws);
    const f16* __restrict__ LA = (const f16*)(ws + OFF_LOGA); const f16* __restrict__ U = (const f16*)(ws + OFF_U); const f16* __restrict__ XY = (const f16*)(ws + OFF_LRUXY); f16* __restrict__ YA = (f16*)(ws + OFF_YA);
    const float* __restrict__ AG = (const float*)(ws + OFF_AGG);
    const float* __restrict__ HCr = (const float*)(ws + OFF_HC) + ((seg + 1) & 1) * 4 * LRUW; float* __restrict__ HCw = (float*)(ws + OFF_HC) + (seg & 1) * 4 * LRUW;
    for (int item = fw; item < 2560; item += nfw) {
        const int ck = item & 31, g = (item >> 5) % 20, b = item / 640, c = g * 64 + lane;
        const size_t r0 = (size_t)b * SEGT + ck * 64;
        float H = seg > 0 ? HCr[b * LRUW + c] : 0.f;
        for (int j = 0; j < ck; ++j) { const float Lj = AG[((size_t)(b * 32 + j) * 2) * LRUW + c], Hj = AG[((size_t)(b * 32 + j) * 2 + 1) * LRUW + c]; H = __expf(Lj) * H + Hj; }
        for (int s0 = 0; s0 < 64; s0 += 8) {
            f16 la8[8], u8[8], y8[8];
#pragma unroll
            for (int s = 0; s < 8; ++s) { la8[s] = LA[(r0 + s0 + s) * LRUW + c]; u8[s] = U[(r0 + s0 + s) * LRUW + c]; y8[s] = XY[(r0 + s0 + s) * 2560 + 1280 + c]; }
#pragma unroll
            for (int s = 0; s < 8; ++s) { H = __expf((float)la8[s]) * H + (float)u8[s]; YA[(r0 + s0 + s) * LRUW + c] = (f16)(H * gelu_tanh((float)y8[s])); }
        }
        if (ck == 31) HCw[b * LRUW + c] = H;
    }
}

__device__ __forceinline__ void rwkv_post(const Params& P, int l, int seg) {
    const int tid = otid(), lane = tid & 63, wave = tid >> 6;
    unsigned char* ws = ows(P.ws);
    const int gw = blockIdx.x * 8 + wave, nw = gridDim.x * 8;
    { const f16* Y = (const f16*)(ws + OFF_Y); const f16* R = (const f16*)(ws + OFF_R); const f16* K = (const f16*)(ws + OFF_K); const f16* V = (const f16*)(ws + OFF_V); const f16* G = (const f16*)(ws + OFF_G); f16* YB = (f16*)(ws + OFF_YB);
      const float* rk = P.in[I_RK] + l * 1024; const float* lw = P.in[I_LNW] + l * 1024; const float* lb = P.in[I_LNB] + l * 1024;
      for (int r = gw; r < MS; r += nw) {
          const size_t o = (size_t)r * 1024 + lane * 16; const int c = lane * 16;
          float y[16], rv[16], kv[16], vv[16], gv[16], rkv[16], lwv[16], lbv[16];
          ld8f(Y + o, y); ld8f(Y + o + 8, y + 8); ld8f(R + o, rv); ld8f(R + o + 8, rv + 8); ld8f(K + o, kv); ld8f(K + o + 8, kv + 8); ld8f(V + o, vv); ld8f(V + o + 8, vv + 8); ld8f(G + o, gv); ld8f(G + o + 8, gv + 8);
          ld8g(rk + c, rkv); ld8g(rk + c + 8, rkv + 8); ld8g(lw + c, lwv); ld8g(lw + c + 8, lwv + 8); ld8g(lb + c, lbv); ld8g(lb + c + 8, lbv + 8);
          float s = 0.f, bo = 0.f;
#pragma unroll
          for (int e = 0; e < 16; ++e) { s += y[e]; bo += rv[e] * kv[e] * rkv[e]; }
          s += __shfl_xor(s, 1); s += __shfl_xor(s, 2); bo += __shfl_xor(bo, 1); bo += __shfl_xor(bo, 2);
          const float mean = s * (1.f / 64.f); float q = 0.f;
#pragma unroll
          for (int e = 0; e < 16; ++e) { const float d = y[e] - mean; q += d * d; }
          q += __shfl_xor(q, 1); q += __shfl_xor(q, 2);
          const float rs = rsqrtf(q * (1.f / 64.f) + 64e-5f);
          f16x8 o0, o1;
#pragma unroll
          for (int e = 0; e < 16; ++e) { const float v = ((y[e] - mean) * rs * lwv[e] + lbv[e] + bo * vv[e]) * gv[e]; if (e < 8) o0[e] = (f16)v; else o1[e - 8] = (f16)v; }
          *(f16x8*)(YB + o) = o0; *(f16x8*)(YB + o + 8) = o1;
      } }
}

__device__ __forceinline__ void attention(const Params& P, int l, int seg, int gw, int nw, bool dry) {
    const int tid = otid(), lane = tid & 63, wave = tid >> 6;
    unsigned char* ws = ows(P.ws);
    { f16* Q = (f16*)(ws + OFF_Q); const f16* KN = (const f16*)(ws + OFF_KN); const f16* VT = (const f16*)(ws + OFF_VT);
      const float* sinks = P.in[I_SINK] + l * 16;
      const int qi = lane & 15, quad = lane >> 4;
      for (int u = gw; u < (MS / 16) * 16; u += nw) {
          const int tile = u >> 4, h = u & 15, kvh = h >> 2, r0 = tile * 16, b = r0 >> 11, pos0 = seg * SEGT + (r0 & 2047);
          const f16* qp = Q + (size_t)(r0 + qi) * 1024 + h * 64 + quad * 8;
          const f16x8 qf0 = *(const f16x8*)qp, qf1 = *(const f16x8*)(qp + 32);
          f32x4 sc[10];
          const int qpos = pos0 + qi;
          const f16* kbase = KN + (size_t)b * SEQ * 256 + kvh * 64 + quad * 8;
          f16x8 kf[10][2];
#pragma unroll
          for (int tt = 0; tt < 10; ++tt) {
              int kr = pos0 - 144 + 32 * (tt >> 1) + (qi >> 2) * 8 + (tt & 1) * 4 + (qi & 3); kr = kr < 0 ? 0 : kr;
              const f16* kp = kbase + (size_t)kr * 256;
              kf[tt][0] = *(const f16x8*)kp; kf[tt][1] = *(const f16x8*)(kp + 32);
          }
          f16x8 vf[5][4];
#pragma unroll
          for (int gI = 0; gI < 5; ++gI) {
              int kv0 = pos0 - 144 + 32 * gI + quad * 8; kv0 = kv0 < 0 ? 0 : kv0;
#pragma unroll
              for (int dt = 0; dt < 4; ++dt) vf[gI][dt] = *(const f16x8*)(VT + ((size_t)((b * 4 + kvh) * 64 + dt * 16 + qi)) * SEQ + kv0);
          }
#pragma unroll
          for (int tt = 0; tt < 10; ++tt) {
              f32x4 s = (f32x4){0.f, 0.f, 0.f, 0.f};
              s = __builtin_amdgcn_mfma_f32_16x16x32_f16(kf[tt][0], qf0, s, 0, 0, 0);
              s = __builtin_amdgcn_mfma_f32_16x16x32_f16(kf[tt][1], qf1, s, 0, 0, 0);
#pragma unroll
              for (int j = 0; j < 4; ++j) { const int kpos = pos0 - 144 + 32 * (tt >> 1) + quad * 8 + (tt & 1) * 4 + j; const bool ok = (kpos >= 0) && (kpos <= qpos) && (qpos - kpos < 128); s[j] = ok ? s[j] : -1e30f; }
              sc[tt] = s;
          }
          float m = -1e30f;
#pragma unroll
          for (int tt = 0; tt < 10; ++tt) m = fmaxf(m, fmaxf(fmaxf(sc[tt][0], sc[tt][1]), fmaxf(sc[tt][2], sc[tt][3])));
          m = fmaxf(m, __shfl_xor(m, 16)); m = fmaxf(m, __shfl_xor(m, 32));
          const float sink = sinks[h]; m = fmaxf(m, sink);
          float sum = 0.f;
#pragma unroll
          for (int tt = 0; tt < 10; ++tt)
#pragma unroll
              for (int j = 0; j < 4; ++j) { const float e = __expf(sc[tt][j] - m); sc[tt][j] = e; sum += e; }
          sum += __shfl_xor(sum, 16); sum += __shfl_xor(sum, 32);
          const float inv = 1.f / (sum + __expf(sink - m));
          f32x4 o[4];
#pragma unroll
          for (int dt = 0; dt < 4; ++dt) o[dt] = (f32x4){0.f, 0.f, 0.f, 0.f};
#pragma unroll
          for (int gI = 0; gI < 5; ++gI) {
              f16x8 pf;
#pragma unroll
              for (int j = 0; j < 4; ++j) { pf[j] = (f16)(sc[2 * gI][j] * inv); pf[4 + j] = (f16)(sc[2 * gI + 1][j] * inv); }
#pragma unroll
              for (int dt = 0; dt < 4; ++dt) o[dt] = __builtin_amdgcn_mfma_f32_16x16x32_f16(vf[gI][dt], pf, o[dt], 0, 0, 0);
          }
          f16* op = (dry ? (f16*)(ws + OFF_KVRAW) + (size_t)((r0 + qi) & 4095) * 1024 : Q + (size_t)(r0 + qi) * 1024) + h * 64 + quad * 4;
#pragma unroll
          for (int dt = 0; dt < 4; ++dt) { f16x4 ov; ov[0] = (f16)o[dt][0]; ov[1] = (f16)o[dt][1]; ov[2] = (f16)o[dt][2]; ov[3] = (f16)o[dt][3]; *(f16x4*)(op + dt * 16) = ov; }
      } }
}

constexpr int PH_PER_SEG = 11, PH_PER_LAYER = 1 + NSEG * PH_PER_SEG, N_PHASES = 1 + 2 * PH_PER_LAYER;

struct Job { const f16* A; const f16* Bt; int lda, ldb, nt, N, cshift, kind, lru, hm; };
__device__ __forceinline__ int gemm_jobs(int sub, int l) { return sub == 1 ? 1 : sub == 3 ? (l == 1 ? 5 : 4) : sub == 7 ? 3 : (sub == 8 || sub == 10 || sub == 11) ? 1 : 0; }
__device__ __forceinline__ Job make_job(unsigned char* ws, int sub, int j, int l) {
    const f16* W = (const f16*)(ws + OFF_W);
    switch (sub) {
    case 1: return Job{(const f16*)(ws + OFF_HN), W + W_IN, 1024, 1024, 16, l == 0 ? 10752 : NIN, 0, 0, 0, 0};
    case 3:
        switch (j) {
        case 0: return Job{(const f16*)(ws + OFF_XA), W + W_LG, 1280, 1280, 4, 2560, 0, 1, 1, 0};
        case 1: return Job{(const f16*)(ws + OFF_ALORA), W + W_W2, 512, 128, 2, 1024, 64, 2, 0, 0};
        case 2: return Job{(const f16*)(ws + OFF_ALORA) + 128, W + W_A2, 512, 128, 2, 1024, 192, 3, 0, 0};
        case 3: return Job{(const f16*)(ws + OFF_ALORA) + 256, W + W_G2, 512, 256, 4, 1024, 128, 4, 0, 0};
        default: return Job{(const f16*)(ws + OFF_V1O), W + W_V2, 256, 128, 2, 1024, 0, 5, 0, 0};
        }
    case 7:
        switch (j) {
        case 0: return Job{(const f16*)(ws + OFF_YA), W + W_LO, 1280, 1280, 20, 1024, 0, 6, 0, 1};
        case 1: return Job{(const f16*)(ws + OFF_YB), W + W_RO, 1024, 1024, 16, 1024, 0, 7, 0, 1};
        default: return Job{(const f16*)(ws + OFF_Q), W + W_AO, 1024, 1024, 16, 1024, 0, 8, 0, 1};
        }
    case 8: return Job{(const f16*)(ws + OFF_MIXED), W + W_OUT, 1024, 1024, 16, 1024, 0, 9, 0, 1};
    case 10: return Job{(const f16*)(ws + OFF_H), W + W_FI, 1024, 1024, 16, 5632, 0, 10, 0, 0};
    default: return Job{(const f16*)(ws + OFF_FFH), W + W_FO, DFF, DFF, 44, 1024, 0, 11, 0, 1};
    }
}

__global__ void __launch_bounds__(NTHR) fwd_kernel(Params P) {
    extern __shared__ __attribute__((aligned(16))) unsigned char smem[];
    LAS unsigned char* lds = (LAS unsigned char*)smem;
    float* ldsf = (float*)smem;
    unsigned char* ws = ows(P.ws);
    const int G = gridDim.x, cid = blockIdx.x;
    unsigned nbar = 0;
    volatile LAS unsigned* xst = (volatile LAS unsigned*)(lds + 155136);
    if (threadIdx.x == 0) { xst[0] = 0u; xst[1] = 0u; }
    __syncthreads();
    XcdBarrier xbar; xbar.bar = (unsigned*)(ws + OFF_BAR); xbar.x = 0; xbar.st = xst;
    if (P.coop) xbar = xcd_barrier_post((unsigned*)(ws + OFF_BAR), xst);
#if PROBE
    volatile float* tcl = (volatile float*)(smem + 152000); volatile unsigned long long* tpl = (volatile unsigned long long*)(smem + 152064);
    if (threadIdx.x == 0) { for (int i = 0; i < 8; ++i) tcl[i] = 0.f; tpl[0] = __builtin_amdgcn_s_memrealtime(); tpl[1] = tpl[0]; }
#endif
    for (int ph = P.ph_lo; ph < P.ph_hi; ++ph) {
        if (ph == 0) { if (PHON(12)) phase_mod(P, ldsf); }
        else {
            const int p = ph - 1, l = p / PH_PER_LAYER, q = p % PH_PER_LAYER;
            const float* xin = l == 0 ? P.in[I_X] : P.out;
            if (q == 0) { if (PHON(13)) phase_prep(P, l, ldsf); phase_norm(P, xin, l, 0, 0, OFF_HN, blockIdx.x * 8 + (otid() >> 6), gridDim.x * 8); }
            else {
                const int seg = (q - 1) / PH_PER_SEG, sub = (q - 1) % PH_PER_SEG + 1;
                const int nj = gemm_jobs(sub, l);
#if DUP_SUB >= 0
                if (sub == DUP_SUB) { if (sub == 5) phase_rwscan(P, l, seg, ldsf, true); else if (sub == 6) rwkv_post(P, l, seg); else if (sub == 4) phase_rwprep(P, l, seg);
                    else if (nj > 0) for (int j = 0; j < nj; ++j) { const Job jb = make_job(ws, sub, j, l); pg8::Gemm g{jb.A, jb.Bt, jb.lda, jb.ldb, jb.nt}; pg8::StaticOrder S; S.init(MS, jb.N, G, (cid + jb.cshift) % G, jb.lru, jb.hm); EpiDispatch ED{jb.kind, P, l, seg}; pg8::gemm_phase(lds, g, S, ED); }
                    if (P.coop) { xcd_barrier(xbar); } }
#endif
                if (nj > 0) {
                    if (PHON(1)) for (int j = 0; j < nj; ++j) {
                        const Job jb = make_job(ws, sub, j, l);
                        pg8::Gemm g{jb.A, jb.Bt, jb.lda, jb.ldb, jb.nt}; pg8::StaticOrder S; S.init(MS, jb.N, G, (cid + jb.cshift) % G, jb.lru, jb.hm);
                        EpiDispatch ED{jb.kind, P, l, seg};
                        pg8::gemm_phase(lds, g, S, ED);
                    }
                } else {
                    switch (sub) {
                    case 2: if (PHON(2)) phase_elem(P, l, seg); break;
                    case 4: if (PHON(4)) { phase_rwprep(P, l, seg); lru_agg(P, blockIdx.x * 8 + (otid() >> 6), gridDim.x * 8); } break;
                    case 5: if (PHON(5)) phase_rwscan(P, l, seg, ldsf, false); break;
                    case 6: if (PHON(6)) rwkv_post(P, l, seg); break;
                    default: if (PHON(9)) phase_norm(P, P.out, l, seg, 1, OFF_H, blockIdx.x * 8 + (otid() >> 6), gridDim.x * 8); break;
                    }
                }
            }
        }
        if (P.coop && ph + 1 < P.ph_hi) { if (P.coop == 2) cg::this_grid().sync(); else xcd_barrier(xbar); }
#if DUP_SYNC
        if (P.coop && ph + 1 < P.ph_hi) { xcd_barrier(xbar); }
#endif
#if PROBE
        if (threadIdx.x == 0) { const unsigned long long tn = __builtin_amdgcn_s_memrealtime(); const float d = (float)(tn - tpl[0]); tpl[0] = tn;
          int cls = 4; if (ph > 0) { const int q = (ph - 1) % PH_PER_LAYER; if (q > 0) { const int sub = (q - 1) % PH_PER_SEG; cls = sub == 5 ? 0 : sub == 6 ? 1 : (sub == 1 || sub == 3 || sub == 7 || sub == 8 || sub == 10 || sub == 11) ? 2 : 3; } }
          tcl[cls] += d; }
#endif
    }
#if PROBE
    { float* fr = (float*)(ws + OFF_SP + 16384);
      if (blockIdx.x == 0 && threadIdx.x == 0) { const float tot = (float)(tpl[0] - tpl[1]); fr[0] = tcl[PC1] / tot; fr[1] = tcl[PC2] / tot; }
      cg::this_grid().sync();
      const float f1 = fr[0], f2 = fr[1]; const int nz = (int)(f1 * 32768.f);
      for (int r = blockIdx.x; r < nz; r += gridDim.x) for (int c = threadIdx.x; c < 1024; c += NTHR) P.out[(size_t)r * 1024 + c] = 0.f;
      if (blockIdx.x == gridDim.x - 1 && threadIdx.x == 0) P.out[(size_t)32767 * 1024 + 1023] = 10000.f * f2; }
#endif
}

extern "C" void kernel_launch(void* const* d_in, const int* in_sizes, int n_in, void* d_out, int out_size, void* d_ws, size_t ws_size, hipStream_t stream) {
    static int grid = 0;
    if (grid == 0) {
        int dev = 0, cus = 0, per_cu = 0;
        hipGetDevice(&dev); hipDeviceGetAttribute(&cus, hipDeviceAttributeMultiprocessorCount, dev);
        hipFuncSetAttribute((const void*)fwd_kernel, hipFuncAttributeMaxDynamicSharedMemorySize, LDS_BYTES);
        hipOccupancyMaxActiveBlocksPerMultiprocessor(&per_cu, (const void*)fwd_kernel, NTHR, LDS_BYTES);
        if (per_cu < 1) per_cu = 1;
        grid = cus * per_cu;
        if (n_in != 35 || ws_size < WS_END) { fprintf(stderr, "kernel_launch: unexpected n_in %d / ws_size %zu\n", n_in, ws_size); grid = -1; }
    }
    if (grid < 0) return;
    Params p{};
    for (int i = 0; i < 35; ++i) p.in[i] = (const float*)d_in[i];
    p.out = (float*)d_out; p.ws = (unsigned char*)d_ws;
#if COOP
    hipMemsetAsync((char*)d_ws + OFF_BAR, 0, 16384, stream);
    p.ph_lo = 0; p.ph_hi = N_PHASES; p.coop = 1;
    void* args[] = {&p};
    hipError_t e = hipLaunchCooperativeKernel((const void*)fwd_kernel, dim3(grid), dim3(NTHR), args, LDS_BYTES, stream);
    if (e != hipSuccess) fprintf(stderr, "cooperative launch failed: %s (grid %d)\n", hipGetErrorString(e), grid);
#else
    for (int ph = 0; ph < N_PHASES; ++ph) {
        p.ph_lo = ph; p.ph_hi = ph + 1; p.coop = 0;
        hipLaunchKernelGGL(fwd_kernel, dim3(grid), dim3(NTHR), LDS_BYTES, stream, p);
    }
#endif
}
```

```cpp
#include <hip/hip_runtime.h>
#include <hip/hip_cooperative_groups.h>
#include <cstdio>
#include <cstdint>
namespace cg = cooperative_groups;

#ifndef COOP
#define COOP 1
#endif
#ifndef PROBE
#define PROBE 0
#endif
#ifndef PC1
#define PC1 0
#endif
#ifndef PC2
#define PC2 1
#endif
#ifndef DUP_SUB
#define DUP_SUB -1
#endif
#ifndef DUP_SYNC
#define DUP_SYNC 0
#endif
#ifndef PHMASK
#define PHMASK 0xFFFF
#endif
#define PHON(i) ((PHMASK >> (i)) & 1)
#ifndef TSEL
#define TSEL 0xFF
#endif
#define TS(i) ((TSEL >> (i)) & 1)
#ifndef EPIMASK
#define EPIMASK 0xFFFF
#endif
#define EPON(i) ((EPIMASK >> (i)) & 1)

#define LAS __attribute__((address_space(3)))
typedef _Float16 f16;
typedef _Float16 f16x8 __attribute__((ext_vector_type(8)));
typedef _Float16 f16x4 __attribute__((ext_vector_type(4)));
typedef float f32x4 __attribute__((ext_vector_type(4)));
typedef float f32x2 __attribute__((ext_vector_type(2)));

constexpr int NB = 4, SEQ = 8192, DM = 1024, TT = NB * SEQ;
constexpr int SEGT = 2048, NSEG = SEQ / SEGT, MS = NB * SEGT;
constexpr int LRUW = 1280, DFF = 2816, INC = 10528, RWC = 3360;
constexpr int NIN = 11008;
constexpr int NTHR = 512;
constexpr int LDS_BYTES = 155648;

constexpr size_t MiB = 1u << 20;
constexpr size_t OFF_MOD = 0;
constexpr size_t OFF_CONVC = 256 * 1024;
constexpr size_t OFF_RKVC = 384 * 1024;
constexpr size_t OFF_LORAC = 512 * 1024;
constexpr size_t OFF_HC = 640 * 1024;
constexpr size_t OFF_BAR = 768 * 1024;
constexpr size_t OFF_SP = 704 * 1024;
constexpr size_t OFF_STATE = 1 * MiB;
constexpr size_t OFF_W = 2 * MiB;
constexpr size_t OFF_VFIRST = 58 * MiB;
constexpr size_t OFF_KN = 122 * MiB;
constexpr size_t OFF_VT = 138 * MiB;
constexpr size_t OFF_H = 154 * MiB;
constexpr size_t OFF_LRUXY = 170 * MiB;
constexpr size_t OFF_RKV = 210 * MiB;
constexpr size_t OFF_LORAR = 258 * MiB;
constexpr size_t OFF_ALORA = 266 * MiB;
constexpr size_t OFF_Q = 274 * MiB;
constexpr size_t OFF_KVRAW = 290 * MiB;
constexpr size_t OFF_GATES = 298 * MiB;
constexpr size_t OFF_V1O = 346 * MiB;
constexpr size_t OFF_XA = 350 * MiB;
constexpr size_t OFF_LOGA = 370 * MiB;
constexpr size_t OFF_U = 390 * MiB;
constexpr size_t OFF_LD = 410 * MiB;
constexpr size_t OFF_A = 426 * MiB;
constexpr size_t OFF_G = 442 * MiB;
constexpr size_t OFF_VMIX = 458 * MiB;
constexpr size_t OFF_KK = 474 * MiB;
constexpr size_t OFF_R = OFF_H, OFF_K = OFF_LORAR, OFF_V = OFF_XA, OFF_YA = OFF_RKV, OFF_Y = 230 * MiB, OFF_FFH = OFF_LRUXY;
constexpr size_t OFF_MERGED = OFF_LD, OFF_MIXED = OFF_G, OFF_YB = OFF_VMIX;
constexpr size_t OFF_AGG = 56 * MiB;
constexpr size_t OFF_HN = 490 * MiB;
constexpr size_t WS_END = 506 * MiB;
constexpr size_t W_IN = 0, W_LG = W_IN + (size_t)NIN * 1024, W_LO = W_LG + 2560 * 1280, W_RO = W_LO + 1024 * 1280, W_AO = W_RO + 1024 * 1024, W_OUT = W_AO + 1024 * 1024,
                 W_FI = W_OUT + 1024 * 1024, W_FO = W_FI + 5632 * 1024, W_W2 = W_FO + 1024 * 2816, W_A2 = W_W2 + 1024 * 128, W_G2 = W_A2 + 1024 * 128, W_V2 = W_G2 + 1024 * 256, W_TOT = W_V2 + 1024 * 128;
static_assert(W_TOT * 2 <= 56 * MiB, "weights");

struct Params { const float* in[35]; float* out; unsigned char* ws; int ph_lo, ph_hi; int coop; int pad; };
enum { I_X = 0, I_C, I_WADA, I_BADA, I_WIN, I_CONVW, I_CONVB, I_LRUWA, I_LRUBA, I_LRUWX, I_LRUBX, I_LAM, I_WLRUO, I_MU, I_W0, I_W2, I_A0, I_A2, I_G2, I_KK, I_KA, I_RK, I_LNW, I_LNB,
       I_V0, I_V1, I_V2, I_WRWO, I_QG, I_KG, I_SINK, I_WATTO, I_WOUT, I_WFI, I_WFO };

__device__ __forceinline__ int otid() { int t = threadIdx.x; asm volatile("" : "+v"(t)); return t; }
__device__ __forceinline__ unsigned char* ows(unsigned char* p) { asm volatile("" : "+s"(p)); return p; }
__device__ __forceinline__ float gelu_tanh(float x) { const float u = 0.7978845608028654f * (x + 0.044715f * x * x * x); const float t = 1.f - 2.f / (1.f + __expf(2.f * u)); return 0.5f * x * (1.f + t); }
__device__ __forceinline__ float sigm(float x) { return 1.f / (1.f + __expf(-x)); }
__device__ __forceinline__ float wave_sum(float v) {
#pragma unroll
    for (int o = 1; o < 64; o <<= 1) v += __shfl_xor(v, o);
    return v;
}
template <int CTRL> __device__ __forceinline__ float dppf(float x) { return __builtin_bit_cast(float, __builtin_amdgcn_update_dpp(0, __builtin_bit_cast(int, x), CTRL, 0xf, 0xf, false)); }
__device__ __forceinline__ float red16(float x) { x += dppf<0x128>(x); x += dppf<0x124>(x); x += dppf<0x122>(x); x += dppf<0x121>(x); return x; }
__device__ __forceinline__ int grow(int r, int seg) { return (r >> 11) * SEQ + seg * SEGT + (r & (SEGT - 1)); }

#define XB_TMO      128
#define XB_XCNT(j)  (256  + 64 * (j))
#define XB_XSUB(j)  (1280 + 64 * (j))
#define XB_XGEN(j)  (2304 + 64 * (j))
#define XB_TOP      3328
#define XB_TOPGEN   3392
#define XCD_BAR_WORDS 3456
#define XB_SPIN_CAP (1u << 18)

__device__ __forceinline__ unsigned xb_ld(unsigned* p)              { return __hip_atomic_load(p, __ATOMIC_RELAXED, __HIP_MEMORY_SCOPE_AGENT); }
__device__ __forceinline__ unsigned xb_add(unsigned* p, unsigned v) { return __hip_atomic_fetch_add(p, v, __ATOMIC_RELAXED, __HIP_MEMORY_SCOPE_AGENT); }
__device__ __forceinline__ unsigned xb_xcc_id() { return (unsigned)__builtin_amdgcn_s_getreg((3 << 11) | 20) & 0xFu; }
#define XB_SPIN(cond, bar) do { unsigned _sp = 0; while (cond) { __builtin_amdgcn_s_sleep(1); \
    if ((++_sp & 255u) == 0u) { if (xb_ld(&(bar)[XB_TMO])) break; if (_sp > XB_SPIN_CAP) { atomicAdd(&(bar)[XB_TMO], 1u); break; } } } } while (0)

struct XcdBarrier {
    unsigned* bar; unsigned x;
    volatile LAS unsigned* st;
};

__device__ __forceinline__ XcdBarrier xcd_barrier_post(unsigned* bar, volatile LAS unsigned* st) {
    XcdBarrier b; b.bar = bar; b.x = xb_xcc_id(); b.st = st;
    if (threadIdx.x == 0) (void)xb_add(&bar[XB_XCNT(b.x)], 1u);
    return b;
}
__device__ __forceinline__ void xcd_barrier_complete(unsigned* bar, unsigned x, unsigned& nloc, unsigned& nx) {
    const unsigned G = gridDim.x * gridDim.y * gridDim.z;
    unsigned sum, cnt, mine, sp = 0u;
    for (;;) {
        sum = 0u; cnt = 0u; mine = 0u;
#pragma unroll
        for (unsigned j = 0; j < 16; ++j) { const unsigned c = xb_ld(&bar[XB_XCNT(j)]); sum += c; cnt += (c > 0u) ? 1u : 0u; mine = (j == x) ? c : mine; }
        if (sum == G) break;
        __builtin_amdgcn_s_sleep(1);
        if ((++sp & 255u) == 0u) { if (xb_ld(&bar[XB_TMO])) break; if (sp > XB_SPIN_CAP) { atomicAdd(&bar[XB_TMO], 1u); break; } }
    }
    nloc = mine > 0u ? mine : 1u; nx = cnt > 0u ? cnt : 1u;
}

__device__ __forceinline__ void xcd_barrier(const XcdBarrier& b) {
    asm volatile("s_waitcnt vmcnt(0)" ::: "memory");
    __syncthreads();
    if (threadIdx.x == 0) {
        unsigned* bar = b.bar;
        __builtin_amdgcn_s_waitcnt(0);
        unsigned nloc = b.st[0], nx = b.st[1];
        if (nloc == 0u) { xcd_barrier_complete(bar, b.x, nloc, nx); b.st[0] = nloc; b.st[1] = nx; }
        const unsigned old = xb_add(&bar[XB_XSUB(b.x)], 1u);
        const unsigned gen = old / nloc;
        if (old + 1u == (gen + 1u) * nloc) {
            __builtin_amdgcn_fence(__ATOMIC_RELEASE, "agent");
            asm volatile("s_waitcnt vmcnt(0)" ::: "memory");
            const unsigned og = xb_add(&bar[XB_TOP], 1u);
            const unsigned tg = og / nx;
            if (og + 1u == (tg + 1u) * nx) xb_add(&bar[XB_TOPGEN], 1u);
            else XB_SPIN(xb_ld(&bar[XB_TOPGEN]) == tg, bar);
            __builtin_amdgcn_fence(__ATOMIC_ACQUIRE, "agent");
            xb_add(&bar[XB_XGEN(b.x)], 1u);
            asm volatile("s_waitcnt vmcnt(0)" ::: "memory");
        } else {
            XB_SPIN(xb_ld(&bar[XB_XGEN(b.x)]) == gen, bar);
            __builtin_amdgcn_fence(__ATOMIC_ACQUIRE, "agent");
            asm volatile("s_waitcnt vmcnt(0)" ::: "memory");
        }
    }
    __syncthreads();
}


__device__ __forceinline__ void grid_bar(unsigned* ctr, unsigned target) {
    asm volatile("s_waitcnt vmcnt(0)" ::: "memory");
    __syncthreads();
    if (threadIdx.x == 0) {
        __builtin_amdgcn_fence(__ATOMIC_RELEASE, "agent");
        asm volatile("s_waitcnt vmcnt(0)" ::: "memory");
        __hip_atomic_fetch_add(ctr, 1u, __ATOMIC_RELAXED, __HIP_MEMORY_SCOPE_AGENT);
        while (__hip_atomic_load(ctr, __ATOMIC_RELAXED, __HIP_MEMORY_SCOPE_AGENT) < target) __builtin_amdgcn_s_sleep(1);
        __builtin_amdgcn_fence(__ATOMIC_ACQUIRE, "agent");
        asm volatile("s_waitcnt vmcnt(0)" ::: "memory");
    }
    __syncthreads();
}

namespace pg8 {
constexpr int BM = 256, BK = 64, HALF = 128, HTB = HALF * BK * 2, STAGE_BYTES = 8 * HTB, NXCD = 8, WGM = 8;
__host__ __device__ __forceinline__ int lds_byte(int r, int c) { const int st = (r >> 4) * 2 + (c >> 5), rr = r & 15, cc = c & 31, ob = rr * 64 + cc * 2; return st * 1024 + (ob ^ (((ob >> 9) & 1) << 5)); }
__host__ __device__ __forceinline__ void stage_rc(int b, int& R, int& C) { const int st = b / 1024, sb = b % 1024, swz = sb ^ (((sb >> 9) & 1) << 5); R = (st >> 1) * 16 + swz / 64; C = (st & 1) * 32 + (swz % 64) / 2; }
__host__ __device__ __forceinline__ int perm32(int rho) { const int n = rho >> 4, i = rho & 15; return 8 * (i >> 2) + 4 * n + (i & 3); }
struct Unit { int pm, pn, koff, hs; };
struct Gemm { const f16* A; const f16* Bt; int lda, ldb, nt; };
struct StaticOrder {
    int nM, nN, nwg, G, c, lru, hm;
    __device__ void init(int M, int N, int G_, int c_, int lru_, int hm_) { hm = hm_; nM = (hm ? 2 : 1) * M / BM; nN = N / BM; nwg = nM * nN; G = G_; c = c_; lru = lru_; }
    __device__ bool next(int i, Unit& u) const {
        const long L = (long)i * G + c; if (L >= nwg) return false;
        int wgid = (int)L; { const int q = nwg / NXCD, r = nwg % NXCD, xcd = wgid % NXCD, off = wgid / NXCD; wgid = (xcd < r ? xcd * (q + 1) : r * (q + 1) + (xcd - r) * q) + off; }
        const int nig = WGM * nN, gid = wgid / nig, fm = gid * WGM, gsz = (nM - fm) < WGM ? (nM - fm) : WGM;
        u.pm = fm + ((wgid % nig) % gsz); u.pn = (wgid % nig) / gsz; u.koff = 0; u.hs = 2;
        if (hm) { u.hs = u.pm & 1; u.pm >>= 1; }
        if (lru) { const int j = u.pn; u.koff = j == 0 ? 0 : j == 1 ? 64 : j == 2 ? 192 : j == 3 ? 320 : j == 4 ? 448 : j == 5 ? 640 : j == 6 ? 704 : j == 7 ? 832 : j == 8 ? 960 : 1024; }
        return true;
    }
};
template <class EpiD>
__device__ __forceinline__ void gemm_phase(LAS unsigned char* lds, const Gemm g, const StaticOrder& S, const EpiD& ED) {
    const int tid = otid(), wid = __builtin_amdgcn_readfirstlane(tid >> 6), lane = tid & 63, wr = wid >> 2, wc = wid & 3, fr = lane & 15, fq = lane >> 4;
    const int nt = g.nt;
    unsigned voffA[2], voffB[2];
#pragma unroll
    for (int i = 0; i < 2; ++i) { int R, C; stage_rc(tid * 16 + i * 8192, R, C); const int Rb = (R & ~31) + perm32(R & 31);
        voffA[i] = (unsigned)(R * g.lda + C) * 2u; voffB[i] = (unsigned)(Rb * g.ldb + C) * 2u; }
    const size_t kstep = (size_t)(BK * 2);
    const size_t hstepA = (size_t)HALF * g.lda * 2, hstepB = (size_t)HALF * g.ldb * 2;
    const unsigned ldsw = (unsigned)wid * 1024u;
    const int aoff = lds_byte(wr * 64 + fr, fq * 8), boff = lds_byte(wc * 32 + fr, fq * 8);
#define PG8_SA(b, h) (((b) * 2 + (h)) * HTB)
#define PG8_SB(b, h) ((4 + (b) * 2 + (h)) * HTB)
#define PG8_STAGE(bufoff, gbase, voff) do { _Pragma("unroll") for (int _i = 0; _i < 2; ++_i) \
        __builtin_amdgcn_global_load_lds((const unsigned*)((const char*)(gbase) + (voff)[_i]), (LAS unsigned*)(lds + (bufoff) + ldsw + _i * 8192), 16, 0, 0); } while (0)
#define PG8_LDA(dst, b, h) do { _Pragma("unroll") for (int m = 0; m < 4; ++m) _Pragma("unroll") for (int k = 0; k < 2; ++k) dst[m][k] = *(const LAS f16x8*)(lds + PG8_SA(b, h) + aoff + m * 2048 + k * 1024); } while (0)
#define PG8_LDB(dst, b, h) do { _Pragma("unroll") for (int n = 0; n < 2; ++n) _Pragma("unroll") for (int k = 0; k < 2; ++k) dst[n][k] = *(const LAS f16x8*)(lds + PG8_SB(b, h) + boff + n * 2048 + k * 1024); } while (0)
#define PG8_MMA(ai, bj, At, Bt) do { __builtin_amdgcn_s_setprio(1); _Pragma("unroll") for (int m = 0; m < 4; ++m) _Pragma("unroll") for (int n = 0; n < 2; ++n) _Pragma("unroll") for (int k = 0; k < 2; ++k) \
        acc[ai][bj][m][n] = __builtin_amdgcn_mfma_f32_16x16x32_f16(Bt[n][k], At[m][k], acc[ai][bj][m][n], 0, 0, 0); __builtin_amdgcn_s_setprio(0); } while (0)
#define PG8_WAIT_V(n) asm volatile("s_waitcnt vmcnt(" #n ")" ::: "memory")
#define PG8_WAIT_L(n) asm volatile("s_waitcnt lgkmcnt(" #n ")" ::: "memory")
#define PG8_BAR __builtin_amdgcn_s_barrier()
#define PG8_SCHED __builtin_amdgcn_sched_barrier(0)
    Unit cur, nxt; int ui = 0;
    if (!S.next(0, cur)) return;
    f32x4 acc[2][2][4][2];
#pragma unroll
    for (int a = 0; a < 2; ++a)
#pragma unroll
        for (int b = 0; b < 2; ++b)
#pragma unroll
            for (int m = 0; m < 4; ++m)
#pragma unroll
                for (int n = 0; n < 2; ++n) acc[a][b][m][n] = (f32x4){0.f, 0.f, 0.f, 0.f};
    f16x8 At[4][2], B0[2][2], B1[2][2];
    const char* cA = (const char*)g.A + (size_t)cur.pm * 2 * hstepA + (size_t)cur.koff * 2; const char* cB = (const char*)g.Bt + (size_t)cur.pn * 2 * hstepB + (size_t)cur.koff * 2;
    PG8_STAGE(PG8_SB(0, 0), cB, voffB); PG8_STAGE(PG8_SB(0, 1), cB + hstepB, voffB); PG8_STAGE(PG8_SA(0, 0), cA, voffA); PG8_STAGE(PG8_SA(0, 1), cA + hstepA, voffA);
    if (wr == 1) PG8_BAR;
    PG8_WAIT_V(2); PG8_BAR;
    PG8_STAGE(PG8_SB(1, 0), cB + kstep, voffB); PG8_STAGE(PG8_SA(1, 0), cA + kstep, voffA); PG8_STAGE(PG8_SB(1, 1), cB + hstepB + kstep, voffB);
    PG8_WAIT_V(6); PG8_BAR;
    for (;;) {
        const bool has_next = S.next(ui + 1, nxt);
        const char* nA = has_next ? (const char*)g.A + (size_t)nxt.pm * 2 * hstepA + (size_t)nxt.koff * 2 : cA; const char* nB = has_next ? (const char*)g.Bt + (size_t)nxt.pn * 2 * hstepB + (size_t)nxt.koff * 2 : cB;
        for (int t = 0; t < nt; t += 2) {
            const bool last = (t == nt - 2);
            const char* a1 = cA + (size_t)(t + 1) * kstep;
            const char* a2 = last ? nA : cA + (size_t)(t + 2) * kstep; const char* b2 = last ? nB : cB + (size_t)(t + 2) * kstep;
            const char* a3 = a2 + kstep; const char* b3 = b2 + kstep;
            PG8_LDB(B0, 0, 0); PG8_LDB(B1, 0, 1); PG8_SCHED; PG8_LDA(At, 0, 0); PG8_STAGE(PG8_SA(1, 1), a1 + hstepA, voffA);
            PG8_WAIT_V(8); PG8_WAIT_L(0); PG8_BAR; if (cur.hs != 1) { PG8_MMA(0, 0, At, B0); PG8_MMA(0, 1, At, B1); } PG8_BAR; PG8_SCHED;
            PG8_LDA(At, 0, 1); PG8_STAGE(PG8_SB(0, 0), b2, voffB); PG8_STAGE(PG8_SB(0, 1), b2 + hstepB, voffB); PG8_STAGE(PG8_SA(0, 0), a2, voffA);
            PG8_WAIT_V(8); PG8_WAIT_L(0); PG8_BAR; if (cur.hs != 0) { PG8_MMA(1, 0, At, B0); PG8_MMA(1, 1, At, B1); } PG8_BAR; PG8_SCHED;
            PG8_LDB(B0, 1, 0); PG8_LDB(B1, 1, 1); PG8_SCHED; PG8_LDA(At, 1, 0); PG8_STAGE(PG8_SA(0, 1), a2 + hstepA, voffA);
            PG8_WAIT_V(8); PG8_WAIT_L(0); PG8_BAR; if (cur.hs != 1) { PG8_MMA(0, 0, At, B0); PG8_MMA(0, 1, At, B1); } PG8_BAR; PG8_SCHED;
            PG8_LDA(At, 1, 1); PG8_STAGE(PG8_SB(1, 0), b3, voffB); PG8_STAGE(PG8_SB(1, 1), b3 + hstepB, voffB); PG8_STAGE(PG8_SA(1, 0), a3, voffA);
            PG8_WAIT_V(8); PG8_WAIT_L(0); PG8_BAR; if (cur.hs != 0) { PG8_MMA(1, 0, At, B0); PG8_MMA(1, 1, At, B1); } PG8_BAR; PG8_SCHED;
        }
        if (wr == 0) PG8_BAR;
        ED(acc, cur, wr, wc, fr, fq);
        if (!has_next) break;
#pragma unroll
        for (int a = 0; a < 2; ++a)
#pragma unroll
            for (int b = 0; b < 2; ++b)
#pragma unroll
                for (int m = 0; m < 4; ++m)
#pragma unroll
                    for (int n = 0; n < 2; ++n) acc[a][b][m][n] = (f32x4){0.f, 0.f, 0.f, 0.f};
        cur = nxt; cA = nA; cB = nB; ++ui;
        if (wr == 1) PG8_BAR;
    }
    PG8_WAIT_V(0);
    PG8_BAR;
#undef PG8_SA
#undef PG8_SB
#undef PG8_STAGE
#undef PG8_LDA
#undef PG8_LDB
#undef PG8_MMA
#undef PG8_WAIT_V
#undef PG8_WAIT_L
#undef PG8_BAR
#undef PG8_SCHED
}
}

__device__ __forceinline__ void st8(f16* p, const f32x4& a, const f32x4& b) {
    f16x8 v; v[0] = (f16)a[0]; v[1] = (f16)a[1]; v[2] = (f16)a[2]; v[3] = (f16)a[3]; v[4] = (f16)b[0]; v[5] = (f16)b[1]; v[6] = (f16)b[2]; v[7] = (f16)b[3];
    *(f16x8*)p = v;
}
__device__ __forceinline__ void ld8f(const f16* p, float* o) { const f16x8 v = *(const f16x8*)p;
#pragma unroll
    for (int i = 0; i < 8; ++i) o[i] = (float)v[i]; }
__device__ __forceinline__ void ld8g(const float* p, float* o) { const f32x4 a = *(const f32x4*)p, b = *(const f32x4*)(p + 4); o[0] = a[0]; o[1] = a[1]; o[2] = a[2]; o[3] = a[3]; o[4] = b[0]; o[5] = b[1]; o[6] = b[2]; o[7] = b[3]; }

struct EpiProj {
    unsigned char* ws;
    __device__ __forceinline__ void operator()(int row, int pn, int cin, const f32x4& a0, const f32x4& a1, const f32x4& b0, const f32x4& b1) const {
        size_t off; int ld, ct;
        if (pn < 10) { off = OFF_LRUXY; ld = 2560; ct = pn; } else if (pn < 22) { off = OFF_RKV; ld = 3072; ct = pn - 10; } else if (pn < 24) { off = OFF_LORAR; ld = 512; ct = pn - 22; }
        else if (pn < 28) { off = OFF_Q; ld = 1024; ct = pn - 24; } else if (pn < 30) { off = OFF_KVRAW; ld = 512; ct = pn - 28; } else if (pn < 42) { off = OFF_GATES; ld = 3072; ct = pn - 30; }
        else { off = OFF_V1O; ld = 256; ct = 0; }
        f16* p = (f16*)(ws + off) + (size_t)row * ld + ct * 256 + cin;
        st8(p, a0, a1); st8(p + 128, b0, b1);
    }
};
struct EpiLruGate {
    const f16* xa; f16* loga; f16* u; const float* ba; const float* bx; const float* lam;
    __device__ __forceinline__ void operator()(int row, int pn, int cin, const f32x4& a0, const f32x4& a1, const f32x4& b0, const f32x4& b1) const {
        const int c0 = pn * 128 + cin; float xv[8], bav[8], bxv[8], lv[8];
        ld8f(xa + (size_t)row * LRUW + c0, xv); ld8g(ba + c0, bav); ld8g(bx + c0, bxv); ld8g(lam + c0, lv);
        f16x8 ol, ou;
#pragma unroll
        for (int e = 0; e < 8; ++e) {
            const float pa = (e < 4 ? a0[e & 3] : a1[e & 3]) + bav[e], px = (e < 4 ? b0[e & 3] : b1[e & 3]) + bxv[e];
            const float la = -8.f * sigm(pa) * lv[e];
            const float z = 2.f * la;
            const float em = z > -0.5f ? -z * (1.f + z * (0.5f + z * (0.16666667f + z * (0.041666668f + z * 0.0083333338f)))) : 1.f - __expf(z);
            const float mult = sqrtf(fmaxf(em, 0.f));
            ol[e] = (f16)la; ou[e] = (f16)(xv[e] * sigm(px) * mult);
        }
        *(f16x8*)(loga + (size_t)row * LRUW + c0) = ol; *(f16x8*)(u + (size_t)row * LRUW + c0) = ou;
    }
};
template <int MODE> struct EpiLora {
    f16* O; const float* bias;
    __device__ __forceinline__ void operator()(int row, int pn, int cin, const f32x4& a0, const f32x4& a1, const f32x4& b0, const f32x4& b1) const {
#pragma unroll
        for (int bj = 0; bj < 2; ++bj) {
            const int c0 = pn * 256 + bj * 128 + cin; float bv[8];
            if (MODE != 2) ld8g(bias + c0, bv);
            f16x8 o;
#pragma unroll
            for (int e = 0; e < 8; ++e) {
                const float v = bj == 0 ? (e < 4 ? a0[e & 3] : a1[e & 3]) : (e < 4 ? b0[e & 3] : b1[e & 3]);
                float r;
                if (MODE == 0) { const float z = bv[e] + v; const float sp = (z > 15.f) ? __expf(-z) : __logf(1.f + __expf(-z)); const float w = -sp - 0.5f; r = -__expf(w); }
                else if (MODE == 1) r = sigm(bv[e] + v);
                else r = v;
                o[e] = (f16)r;
            }
            *(f16x8*)(O + (size_t)row * 1024 + c0) = o;
        }
    }
};
template <int BR> struct EpiMerge {
    const f16* gates; float* merged; f16* mixed;
    __device__ __forceinline__ void operator()(int row, int pn, int cin, const f32x4& a0, const f32x4& a1, const f32x4& b0, const f32x4& b1) const {
#pragma unroll
        for (int bj = 0; bj < 2; ++bj) {
            const int c0 = pn * 256 + bj * 128 + cin; float gv[8], mv[8];
            ld8f(gates + (size_t)row * 3072 + BR * 1024 + c0, gv);
            float* mp = merged + (size_t)row * 1024 + c0;
            if (BR > 0) ld8g(mp, mv);
            float o[8];
#pragma unroll
            for (int e = 0; e < 8; ++e) {
                const float v = bj == 0 ? (e < 4 ? a0[e & 3] : a1[e & 3]) : (e < 4 ? b0[e & 3] : b1[e & 3]);
                o[e] = (BR > 0 ? mv[e] : 0.f) + sigm(gv[e]) * v;
            }
            if (BR < 2) { *(f32x4*)mp = (f32x4){o[0], o[1], o[2], o[3]}; *(f32x4*)(mp + 4) = (f32x4){o[4], o[5], o[6], o[7]}; }
            else { f16x8 h;
#pragma unroll
                for (int e = 0; e < 8; ++e) h[e] = (f16)o[e];
                *(f16x8*)(mixed + (size_t)row * 1024 + c0) = h; }
        }
    }
};
struct EpiResid {
    const float* xin; float* out; const float* gate  ; int seg;
    __device__ __forceinline__ void operator()(int row, int pn, int cin, const f32x4& a0, const f32x4& a1, const f32x4& b0, const f32x4& b1) const {
        const size_t g = (size_t)grow(row, seg); const int b = row >> 11;
#pragma unroll
        for (int bj = 0; bj < 2; ++bj) {
            const int c0 = pn * 256 + bj * 128 + cin; float xv[8], gv[8];
            ld8g(xin + g * 1024 + c0, xv); ld8g(gate + b * 6144 + c0, gv);
            float o[8];
#pragma unroll
            for (int e = 0; e < 8; ++e) { const float v = bj == 0 ? (e < 4 ? a0[e & 3] : a1[e & 3]) : (e < 4 ? b0[e & 3] : b1[e & 3]); o[e] = xv[e] + gv[e] * v; }
            float* op = out + g * 1024 + c0;
            *(f32x4*)op = (f32x4){o[0], o[1], o[2], o[3]}; *(f32x4*)(op + 4) = (f32x4){o[4], o[5], o[6], o[7]};
        }
    }
};
struct EpiSwiglu {
    f16* ffh;
    __device__ __forceinline__ void operator()(int row, int pn, int cin, const f32x4& a0, const f32x4& a1, const f32x4& b0, const f32x4& b1) const {
        f16x8 o;
#pragma unroll
        for (int e = 0; e < 8; ++e) { const float gt = e < 4 ? a0[e & 3] : a1[e & 3], up = e < 4 ? b0[e & 3] : b1[e & 3]; o[e] = (f16)(gt * sigm(gt) * up); }
        *(f16x8*)(ffh + (size_t)row * DFF + pn * 128 + cin) = o;
    }
};
struct EpiDispatch {
    int kind; const Params& P; int l, seg;
    template <class E> __device__ __forceinline__ void run(const E& e, const f32x4 (&acc)[2][2][4][2], const pg8::Unit& u, int wr, int wc, int fr, int fq) const {
#pragma unroll
        for (int ai = 0; ai < 2; ++ai) { if (u.hs == 1 - ai) continue;
#pragma unroll
            for (int m = 0; m < 4; ++m) {
                const int row = u.pm * 256 + ai * 128 + wr * 64 + m * 16 + fr;
                __builtin_amdgcn_sched_barrier(0);
                e(row, u.pn, wc * 32 + 8 * fq, acc[ai][0][m][0], acc[ai][0][m][1], acc[ai][1][m][0], acc[ai][1][m][1]);
            } }
    }
    __device__ __forceinline__ void operator()(const f32x4 (&acc)[2][2][4][2], const pg8::Unit& u, int wr, int wc, int fr, int fq) const {
        unsigned char* ws = ows(P.ws); const float* const* in = P.in; float* out = P.out; const float* xin = l == 0 ? P.in[I_X] : P.out; const float* mod = (const float*)(ws + OFF_MOD) + (size_t)l * 4 * 6144;
        const f16* gates = (const f16*)(ws + OFF_GATES); float* merged = (float*)(ws + OFF_MERGED); f16* mixed = (f16*)(ws + OFF_MIXED);
        switch (kind) {
        case 0: if (EPON(0)) run(EpiProj{ws}, acc, u, wr, wc, fr, fq); break;
        case 1: if (EPON(1)) run(EpiLruGate{(const f16*)(ws + OFF_XA), (f16*)(ws + OFF_LOGA), (f16*)(ws + OFF_U), in[I_LRUBA] + l * 1280, in[I_LRUBX] + l * 1280, (const float*)(ws + OFF_SP) + l * 1280}, acc, u, wr, wc, fr, fq); break;
        case 2: if (EPON(2)) run(EpiLora<0>{(f16*)(ws + OFF_LD), in[I_W0] + l * 1024}, acc, u, wr, wc, fr, fq); break;
        case 3: if (EPON(3)) run(EpiLora<1>{(f16*)(ws + OFF_A), in[I_A0] + l * 1024}, acc, u, wr, wc, fr, fq); break;
        case 4: if (EPON(4)) run(EpiLora<2>{(f16*)(ws + OFF_G), nullptr}, acc, u, wr, wc, fr, fq); break;
        case 5: if (EPON(5)) run(EpiLora<1>{(f16*)(ws + OFF_VMIX), in[I_V0]}, acc, u, wr, wc, fr, fq); break;
        case 6: if (EPON(6)) run(EpiMerge<0>{gates, merged, mixed}, acc, u, wr, wc, fr, fq); break;
        case 7: if (EPON(7)) run(EpiMerge<1>{gates, merged, mixed}, acc, u, wr, wc, fr, fq); break;
        case 8: if (EPON(8)) run(EpiMerge<2>{gates, merged, mixed}, acc, u, wr, wc, fr, fq); break;
        case 9: if (EPON(9)) run(EpiResid{xin, out, mod + 2048, seg}, acc, u, wr, wc, fr, fq); break;
        case 10: if (EPON(10)) run(EpiSwiglu{(f16*)(ws + OFF_FFH)}, acc, u, wr, wc, fr, fq); break;
        default: if (EPON(11)) run(EpiResid{out, out, mod + 5120, seg}, acc, u, wr, wc, fr, fq); break;
        }
    }
};

template <class Src> __device__ __forceinline__ void prep_w(f16* Wt, int N, int K, const Src& src, float* tile) {
    const int tid = otid(), nkt = K / 64, ntile = (N / 64) * nkt;
    for (int t = blockIdx.x; t < ntile; t += gridDim.x) {
        const int n0 = (t / nkt) * 64, k0 = (t % nkt) * 64;
#pragma unroll
        for (int i = 0; i < 8; ++i) { const int kk = (tid >> 6) + 8 * i, nn = tid & 63; tile[kk * 65 + nn] = src(n0 + nn, k0 + kk); }
        __syncthreads();
#pragma unroll
        for (int i = 0; i < 8; ++i) { const int nn = (tid >> 6) + 8 * i, kk = tid & 63; Wt[(size_t)(n0 + nn) * K + k0 + kk] = (f16)tile[kk * 65 + nn]; }
        __syncthreads();
    }
}

__device__ __forceinline__ void phase_prep(const Params& P, int l, float* tile) {
    f16* W = (f16*)(P.ws + OFF_W);
    { const float* w = P.in[I_WIN] + (size_t)l * 1024 * INC; const float* v1 = P.in[I_V1];
      prep_w(W + W_IN, l == 0 ? 10752 : NIN, 1024, [=](int n, int k) -> float {
          int s;
          if (n < 5632) s = n;
          else if (n < 6144) { const int j = n - 5632; s = j < 64 ? 5632 + j : (j >= 128 && j < 192) ? 5696 + (j - 128) : (j >= 256 && j < 416) ? 5760 + (j - 256) : -1; }
          else if (n < 7168) s = 5920 + (n - 6144);
          else if (n < 7680) s = 6944 + (n - 7168);
          else if (n < 10752) s = 7456 + (n - 7680);
          else { const int j = n - 10752; return j < 32 ? v1[(size_t)k * 32 + j] : 0.f; }
          return s < 0 ? 0.f : w[(size_t)k * INC + s]; }, tile); }
    { const float* wa = P.in[I_LRUWA] + (size_t)l * 16 * 6400; const float* wx = P.in[I_LRUWX] + (size_t)l * 16 * 6400;
      prep_w(W + W_LG, 2560, 1280, [=](int n, int k) -> float {
          const int half = (n & 255) >> 7, c = (n >> 8) * 128 + (n & 127), nb = c / 80, jj = c - nb * 80, kb = k / 80, ii = k - kb * 80;
          if (kb != nb) return 0.f;
          return (half ? wx : wa)[(size_t)(nb * 80 + ii) * 80 + jj]; }, tile); }
    { const float* w = P.in[I_WLRUO] + (size_t)l * 1280 * 1024; prep_w(W + W_LO, 1024, 1280, [=](int n, int k) -> float { return w[(size_t)k * 1024 + n]; }, tile); }
    { const float* w = P.in[I_WRWO] + (size_t)l * 1024 * 1024; prep_w(W + W_RO, 1024, 1024, [=](int n, int k) -> float { return w[(size_t)k * 1024 + n]; }, tile); }
    { const float* w = P.in[I_WATTO] + (size_t)l * 1024 * 1024; prep_w(W + W_AO, 1024, 1024, [=](int n, int k) -> float { return w[(size_t)k * 1024 + n]; }, tile); }
    { const float* w = P.in[I_WOUT] + (size_t)l * 1024 * 1024; prep_w(W + W_OUT, 1024, 1024, [=](int n, int k) -> float { return w[(size_t)k * 1024 + n]; }, tile); }
    { const float* w = P.in[I_WFI] + (size_t)l * 1024 * 5632;
      prep_w(W + W_FI, 5632, 1024, [=](int n, int k) -> float { const int half = (n & 255) >> 7, idx = (n >> 8) * 128 + (n & 127); return w[(size_t)k * 5632 + half * 2816 + idx]; }, tile); }
    { const float* w = P.in[I_WFO] + (size_t)l * 2816 * 1024; prep_w(W + W_FO, 1024, 2816, [=](int n, int k) -> float { return w[(size_t)k * 1024 + n]; }, tile); }
    { const float* w = P.in[I_W2] + (size_t)l * 64 * 1024; prep_w(W + W_W2, 1024, 128, [=](int n, int k) -> float { return k < 64 ? w[(size_t)k * 1024 + n] : 0.f; }, tile); }
    { const float* w = P.in[I_A2] + (size_t)l * 64 * 1024; prep_w(W + W_A2, 1024, 128, [=](int n, int k) -> float { return k < 64 ? w[(size_t)k * 1024 + n] : 0.f; }, tile); }
    { const float* w = P.in[I_G2] + (size_t)l * 160 * 1024; prep_w(W + W_G2, 1024, 256, [=](int n, int k) -> float { return k < 160 ? w[(size_t)k * 1024 + n] : 0.f; }, tile); }
    if (l == 1) { const float* w = P.in[I_V2]; prep_w(W + W_V2, 1024, 128, [=](int n, int k) -> float { return k < 32 ? w[(size_t)k * 1024 + n] : 0.f; }, tile); }
}

__device__ __forceinline__ void phase_mod(const Params& P, float* lds) {
    const int tid = otid(), wave = tid >> 6, lane = tid & 63;
    float* sc = lds;
    float* red = lds + 4096;
    const float* c = P.in[I_C];
    for (int i = tid; i < 4096; i += NTHR) { const float v = c[i]; sc[i] = v * sigm(v); }
    __syncthreads();
    float* mod = (float*)(P.ws + OFF_MOD);
    if (blockIdx.x == 0) for (int i = tid; i < 2560; i += NTHR) ((float*)(P.ws + OFF_SP))[i] = log1pf(expf(-P.in[I_LAM][i]));
    for (int it = blockIdx.x; it < 192; it += gridDim.x) {
        const int l = it / 96, n = (it % 96) * 64 + lane;
        const float* w = P.in[I_WADA] + (size_t)l * 1024 * 6144 + n;
        float a0 = 0.f, a1 = 0.f, a2 = 0.f, a3 = 0.f;
        for (int k0 = wave * 128; k0 < wave * 128 + 128; k0 += 16) {
            float wv[16];
#pragma unroll
            for (int j = 0; j < 16; ++j) wv[j] = w[(size_t)(k0 + j) * 6144];
#pragma unroll
            for (int j = 0; j < 16; ++j) { const int k = k0 + j; a0 += sc[k] * wv[j]; a1 += sc[1024 + k] * wv[j]; a2 += sc[2048 + k] * wv[j]; a3 += sc[3072 + k] * wv[j]; }
        }
        red[(wave * 4 + 0) * 64 + lane] = a0; red[(wave * 4 + 1) * 64 + lane] = a1; red[(wave * 4 + 2) * 64 + lane] = a2; red[(wave * 4 + 3) * 64 + lane] = a3;
        __syncthreads();
        if (tid < 256) { const int b = tid >> 6; float s = P.in[I_BADA][l * 6144 + n];
#pragma unroll
            for (int w8 = 0; w8 < 8; ++w8) s += red[(w8 * 4 + b) * 64 + lane];
            mod[(size_t)(l * 4 + b) * 6144 + n] = s; }
        __syncthreads();
    }
}

__device__ __forceinline__ void phase_norm(const Params& P, const float* xin, int l, int seg, int which  , size_t hoff, int gw, int nw) {
    const int tid = otid(), lane = tid & 63;
    f16* H = (f16*)(ows(P.ws) + hoff);
    for (int r = gw; r < MS; r += nw) {
        const size_t g = (size_t)grow(r, seg); const int b = r >> 11;
        const float* mod = (const float*)(P.ws + OFF_MOD) + (size_t)(l * 4 + b) * 6144 + which * 3072;
        f32x4 v[4]; float ss = 0.f;
#pragma unroll
        for (int i = 0; i < 4; ++i) { v[i] = *(const f32x4*)(xin + g * 1024 + i * 256 + lane * 4); ss += v[i][0] * v[i][0] + v[i][1] * v[i][1] + v[i][2] * v[i][2] + v[i][3] * v[i][3]; }
        ss = wave_sum(ss);
        const float rs = rsqrtf(ss * (1.f / 1024.f) + 1e-6f);
#pragma unroll
        for (int i = 0; i < 4; ++i) { const int c = i * 256 + lane * 4; const f32x4 sh = *(const f32x4*)(mod + c), scl = *(const f32x4*)(mod + 1024 + c); f16x4 o;
#pragma unroll
            for (int e = 0; e < 4; ++e) o[e] = (f16)(v[i][e] * rs * (1.f + scl[e]) + sh[e]);
            *(f16x4*)(H + (size_t)r * 1024 + c) = o; }
    }
}

__device__ __forceinline__ void phase_elem(const Params& P, int l, int seg) {
    const int tid = otid(), lane = tid & 63, gt = blockIdx.x * NTHR + tid, ntot = gridDim.x * NTHR, gw = blockIdx.x * 8 + (tid >> 6), nw = gridDim.x * 8;
    unsigned char* ws = ows(P.ws);
    { const f16* X = (const f16*)(ws + OFF_LRUXY); f16* XA = (f16*)(ws + OFF_XA); f16* cw = (f16*)(ws + OFF_CONVC) + (size_t)(seg & 1) * 4 * 3 * 1280; const f16* cr = (const f16*)(ws + OFF_CONVC) + (size_t)((seg + 1) & 1) * 4 * 3 * 1280;
      const float* w = P.in[I_CONVW] + (size_t)l * 4 * 1280; const float* bia = P.in[I_CONVB] + (size_t)l * 1280;
      for (int it = gt; it < MS * 160; it += ntot) {
          const int r = it / 160, c0 = (it % 160) * 8, b = r >> 11, tl = r & 2047;
          float o[8]; ld8g(bia + c0, o);
#pragma unroll
          for (int j = 0; j < 4; ++j) {
              const int t2 = tl - 3 + j; float xv[8];
              if (t2 >= 0) ld8f(X + (size_t)(r - 3 + j) * 2560 + c0, xv);
              else if (seg > 0) ld8f(cr + (size_t)(b * 3 + (3 + t2)) * 1280 + c0, xv);
              else {
#pragma unroll
                  for (int e = 0; e < 8; ++e) xv[e] = 0.f; }
              float wv[8]; ld8g(w + j * 1280 + c0, wv);
#pragma unroll
              for (int e = 0; e < 8; ++e) o[e] += xv[e] * wv[e];
          }
          f16x8 h;
#pragma unroll
          for (int e = 0; e < 8; ++e) h[e] = (f16)o[e];
          *(f16x8*)(XA + (size_t)r * 1280 + c0) = h;
          if (tl >= SEGT - 3) *(f16x8*)(cw + (size_t)(b * 3 + (tl - (SEGT - 3))) * 1280 + c0) = *(const f16x8*)(X + (size_t)r * 2560 + c0);
      } }
    { const f16* X = (const f16*)(ws + OFF_LORAR); f16* AL = (f16*)(ws + OFF_ALORA); f16* cw = (f16*)(ws + OFF_LORAC) + (size_t)(seg & 1) * 4 * 512; const f16* cr = (const f16*)(ws + OFF_LORAC) + (size_t)((seg + 1) & 1) * 4 * 512;
      const float* mu = P.in[I_MU] + (size_t)l * RWC;
      for (int it = gt; it < MS * 64; it += ntot) {
          const int r = it >> 6, c0 = (it & 63) * 8, b = r >> 11, tl = r & 2047;
          const f16x8 raw = *(const f16x8*)(X + (size_t)r * 512 + c0);
          if (tl == SEGT - 1) *(f16x8*)(cw + b * 512 + c0) = raw;
          int mode, mo;
          if (c0 < 64) { mode = 0; mo = 3072 + c0; } else if (c0 >= 128 && c0 < 192) { mode = 1; mo = 3136 + (c0 - 128); } else if (c0 >= 256 && c0 < 416) { mode = 2; mo = 3200 + (c0 - 256); } else { mode = 3; mo = 0; }
          f16x8 o;
          if (mode == 3) {
#pragma unroll
              for (int e = 0; e < 8; ++e) o[e] = (f16)0.f;
          } else {
              float pv[8];
              if (tl > 0) ld8f(X + (size_t)(r - 1) * 512 + c0, pv);
              else if (seg > 0) ld8f(cr + b * 512 + c0, pv);
              else {
#pragma unroll
                  for (int e = 0; e < 8; ++e) pv[e] = 0.f; }
              float mv[8]; ld8g(mu + mo, mv);
#pragma unroll
              for (int e = 0; e < 8; ++e) { const float x = (float)raw[e]; const float p = x + (pv[e] - x) * mv[e]; o[e] = (f16)(mode == 0 ? tanhf(p) : mode == 1 ? p : sigm(p)); }
          }
          *(f16x8*)(AL + (size_t)r * 512 + c0) = o;
      } }
    { f16* Q = (f16*)(ws + OFF_Q); const f16* KV = (const f16*)(ws + OFF_KVRAW); f16* KN = (f16*)(ws + OFF_KN);
      const float* qg = P.in[I_QG] + l * 64; const float* kg = P.in[I_KG] + l * 64;
      float gv[16]; ld8g(qg + (lane & 3) * 16, gv); ld8g(qg + (lane & 3) * 16 + 8, gv + 8);
      const f32x4 kgv = *(const f32x4*)(kg + (lane & 15) * 4);
      for (int r = gw; r < MS; r += nw) {
          float v[16]; ld8f(Q + (size_t)r * 1024 + lane * 16, v); ld8f(Q + (size_t)r * 1024 + lane * 16 + 8, v + 8);
          float ss = 0.f;
#pragma unroll
          for (int e = 0; e < 16; ++e) ss += v[e] * v[e];
          ss += __shfl_xor(ss, 1); ss += __shfl_xor(ss, 2);
          const float rs = rsqrtf(ss * (1.f / 64.f) + 1e-6f) * 0.125f;
          f16x8 o0, o1;
#pragma unroll
          for (int e = 0; e < 8; ++e) { o0[e] = (f16)(v[e] * rs * gv[e]); o1[e] = (f16)(v[8 + e] * rs * gv[8 + e]); }
          *(f16x8*)(Q + (size_t)r * 1024 + lane * 16) = o0; *(f16x8*)(Q + (size_t)r * 1024 + lane * 16 + 8) = o1;
          const f16x4 kr = *(const f16x4*)(KV + (size_t)r * 512 + lane * 4);
          float kv[4] = {(float)kr[0], (float)kr[1], (float)kr[2], (float)kr[3]};
          float s2 = kv[0] * kv[0] + kv[1] * kv[1] + kv[2] * kv[2] + kv[3] * kv[3];
          s2 += __shfl_xor(s2, 1); s2 += __shfl_xor(s2, 2); s2 += __shfl_xor(s2, 4); s2 += __shfl_xor(s2, 8);
          const float rk = rsqrtf(s2 * (1.f / 64.f) + 1e-6f);
          f16x4 ko; ko[0] = (f16)(kv[0] * rk * kgv[0]); ko[1] = (f16)(kv[1] * rk * kgv[1]); ko[2] = (f16)(kv[2] * rk * kgv[2]); ko[3] = (f16)(kv[3] * rk * kgv[3]);
          *(f16x4*)(KN + (size_t)grow(r, seg) * 256 + lane * 4) = ko;
      } }
    { const f16* KV = (const f16*)(ws + OFF_KVRAW); f16* VT = (f16*)(ws + OFF_VT);
      for (int it = gw; it < (MS / 64) * 4; it += nw) {
          const int tile = it >> 2, kvh = it & 3, r0 = tile * 64, b = r0 >> 11, pos0 = seg * SEGT + (r0 & 2047);
          f16x8 vv[8];
#pragma unroll
          for (int i = 0; i < 8; ++i)
#pragma unroll
              for (int e = 0; e < 8; ++e) vv[i][e] = KV[(size_t)(r0 + i * 8 + e) * 512 + 256 + kvh * 64 + lane];
          f16* dst = VT + ((size_t)((b * 4 + kvh) * 64 + lane)) * SEQ + pos0;
#pragma unroll
          for (int i = 0; i < 8; ++i) *(f16x8*)(dst + i * 8) = vv[i];
      } }
}

__device__ __forceinline__ void phase_rwprep(const Params& P, int l, int seg) {
    const int tid = otid(), lane = tid & 63, gw = blockIdx.x * 8 + (tid >> 6), nw = gridDim.x * 8;
    unsigned char* ws = ows(P.ws);
    const f16* __restrict__ X = (const f16*)(ws + OFF_RKV); const f16* __restrict__ A = (const f16*)(ws + OFF_A); const f16* __restrict__ VM = (const f16*)(ws + OFF_VMIX); f16* VF = (f16*)(ws + OFF_VFIRST);
    f16* __restrict__ R = (f16*)(ws + OFF_R); f16* __restrict__ K = (f16*)(ws + OFF_K); f16* __restrict__ V = (f16*)(ws + OFF_V); f16* __restrict__ KK = (f16*)(ws + OFF_KK);
    f16* __restrict__ cw = (f16*)(ws + OFF_RKVC) + (size_t)(seg & 1) * 4 * 3072; const f16* __restrict__ cr = (const f16*)(ws + OFF_RKVC) + (size_t)((seg + 1) & 1) * 4 * 3072;
    const float* mu = P.in[I_MU] + (size_t)l * RWC; const float* kkw = P.in[I_KK] + l * 1024; const float* kaw = P.in[I_KA] + l * 1024;
    const int half = gw & 1, c = half * 512 + lane * 8;
    float mur[8], muk[8], muv[8], kkv[8], kav[8];
    ld8g(mu + c, mur); ld8g(mu + 1024 + c, muk); ld8g(mu + 2048 + c, muv); ld8g(kkw + c, kkv); ld8g(kaw + c, kav);
    for (int r = gw >> 1; r < MS; r += nw >> 1) {
        const int b = r >> 11, tl = r & 2047; const size_t g = (size_t)grow(r, seg);
        const f16x8 r0 = *(const f16x8*)(X + (size_t)r * 3072 + c), k0 = *(const f16x8*)(X + (size_t)r * 3072 + 1024 + c), v0 = *(const f16x8*)(X + (size_t)r * 3072 + 2048 + c);
        f16x8 pr, pk, pv;
        if (tl > 0) { pr = *(const f16x8*)(X + (size_t)(r - 1) * 3072 + c); pk = *(const f16x8*)(X + (size_t)(r - 1) * 3072 + 1024 + c); pv = *(const f16x8*)(X + (size_t)(r - 1) * 3072 + 2048 + c); }
        else if (seg > 0) { pr = *(const f16x8*)(cr + b * 3072 + c); pk = *(const f16x8*)(cr + b * 3072 + 1024 + c); pv = *(const f16x8*)(cr + b * 3072 + 2048 + c); }
        else {
#pragma unroll
            for (int e = 0; e < 8; ++e) { pr[e] = (f16)0.f; pk[e] = (f16)0.f; pv[e] = (f16)0.f; } }
        const f16x8 a8 = *(const f16x8*)(A + (size_t)r * 1024 + c);
        f16x8 vf8, vm8;
        if (l == 1) { vf8 = *(const f16x8*)(VF + g * 1024 + c); vm8 = *(const f16x8*)(VM + (size_t)r * 1024 + c); }
        if (tl == SEGT - 1) { *(f16x8*)(cw + b * 3072 + c) = r0; *(f16x8*)(cw + b * 3072 + 1024 + c) = k0; *(f16x8*)(cw + b * 3072 + 2048 + c) = v0; }
        float xr[8], xk[8], xv[8], kk[8]; float ss = 0.f;
#pragma unroll
        for (int e = 0; e < 8; ++e) {
            const float rv = (float)r0[e], kv = (float)k0[e], vv = (float)v0[e];
            xr[e] = rv + ((float)pr[e] - rv) * mur[e]; xk[e] = kv + ((float)pk[e] - kv) * muk[e]; xv[e] = vv + ((float)pv[e] - vv) * muv[e];
            kk[e] = xk[e] * kkv[e]; ss += kk[e] * kk[e];
        }
        ss += __shfl_xor(ss, 1); ss += __shfl_xor(ss, 2); ss += __shfl_xor(ss, 4);
        const float rn = rsqrtf(fmaxf(ss, 1e-24f));
        f16x8 oR, oK, oV, oQ;
        if (l == 0) {
#pragma unroll
            for (int e = 0; e < 8; ++e) oV[e] = (f16)xv[e];
            *(f16x8*)(VF + g * 1024 + c) = oV;
        } else {
#pragma unroll
            for (int e = 0; e < 8; ++e) oV[e] = (f16)(xv[e] + ((float)vf8[e] - xv[e]) * (float)vm8[e]);
        }
#pragma unroll
        for (int e = 0; e < 8; ++e) { oR[e] = (f16)xr[e]; oK[e] = (f16)(xk[e] * (1.f + ((float)a8[e] - 1.f) * kav[e])); oQ[e] = (f16)(kk[e] * rn); }
        const size_t o = (size_t)r * 1024 + c;
        *(f16x8*)(R + o) = oR; *(f16x8*)(K + o) = oK; *(f16x8*)(V + o) = oV; *(f16x8*)(KK + o) = oQ;
    }
}

__device__ __forceinline__ void lru_wave(const Params& P, int seg, int fw, int nfw);
__device__ __forceinline__ void attention(const Params& P, int l, int seg, int gw, int nw, bool dry);
__device__ __forceinline__ unsigned lds_ld(LAS unsigned* p) { return __hip_atomic_load(p, __ATOMIC_ACQUIRE, __HIP_MEMORY_SCOPE_WORKGROUP); }
__device__ __forceinline__ void lds_inc(LAS unsigned* p) { __hip_atomic_fetch_add(p, 1u, __ATOMIC_RELEASE, __HIP_MEMORY_SCOPE_WORKGROUP); }
__device__ __forceinline__ void phase_rwscan(const Params& P, int l, int seg, float* lds, bool dry) {
    const int tid = otid(), lane = tid & 63, wave = tid >> 6;
    unsigned char* ws = ows(P.ws);
    constexpr int CH = 32, NCH = SEGT / CH, NBUF = 2;
    float* buf = lds;
    float* vbuf = lds + NBUF * 10240;
    float* yp = vbuf + NBUF * 512;
    LAS unsigned* flg = (LAS unsigned*)(yp + NBUF * 8192);
    if (tid < 8) flg[tid] = 0u;
    __syncthreads();
    if (wave >= 5) {
        const int fw = blockIdx.x * 3 + (wave - 5), nfw = gridDim.x * 3;
        lru_wave(P, seg, fw, nfw);
        attention(P, l, seg, fw, nfw, dry);
        if (seg + 1 < NSEG) phase_norm(P, l == 0 ? P.in[I_X] : P.out, l, seg + 1, 0, OFF_HN, fw, nfw);
        return;
    }
    int cbase = 0;
    for (int item = blockIdx.x; item < 256; item += gridDim.x, cbase += NCH) {
        const int b = item >> 6, h = (item >> 2) & 15, qd = item & 3;
        const size_t rowbase = (size_t)b * SEGT;
        if (wave < 4) {
            float* st = (float*)(ws + OFF_STATE) + ((size_t)item * 256 + tid) * 4;
            f32x2 S01 = (f32x2){0.f, 0.f}, S23 = S01;
            if (seg > 0) { const f32x4 s0 = *(const f32x4*)st; S01 = (f32x2){s0[0], s0[1]}; S23 = (f32x2){s0[2], s0[3]}; }
            const int ks = (lane & 15) * 4, rr = lane >> 4;
            for (int c = 0; c < NCH; ++c) {
                const int cg = cbase + c, p = cg & 1; const unsigned tgt = (unsigned)((cg >> 1) + 1);
                while (lds_ld(flg + p) < tgt) __builtin_amdgcn_s_sleep(1);
                LAS const float* bp = (LAS const float*)(buf + p * 10240 + ks); LAS const float* vp = (LAS const float*)(vbuf + p * 512 + wave * 4 + rr); LAS float* yo = (LAS float*)(yp + p * 8192 + wave * 64 + lane);
                asm volatile("" : "+v"(bp)); asm volatile("" : "+v"(vp)); asm volatile("" : "+v"(yo));
                f32x4 w4 = *(LAS const f32x4*)(bp), k4 = *(LAS const f32x4*)(bp + 2048), a4 = *(LAS const f32x4*)(bp + 4096), b4 = *(LAS const f32x4*)(bp + 6144), r4 = *(LAS const f32x4*)(bp + 8192);
                float v = vp[0];
                f32x4 nw4 = *(LAS const f32x4*)(bp + 64), nk4 = *(LAS const f32x4*)(bp + 2048 + 64), na4 = *(LAS const f32x4*)(bp + 4096 + 64), nb4 = *(LAS const f32x4*)(bp + 6144 + 64), nr4 = *(LAS const f32x4*)(bp + 8192 + 64);
                float nv = vp[16];
#pragma unroll 8
                for (int t = 0; t < CH; ++t) {
                    const int tn = t + 2 < CH ? t + 2 : CH - 1;
                    const f32x4 mw4 = *(LAS const f32x4*)(bp + tn * 64), mk4 = *(LAS const f32x4*)(bp + 2048 + tn * 64), ma4 = *(LAS const f32x4*)(bp + 4096 + tn * 64), mb4 = *(LAS const f32x4*)(bp + 6144 + tn * 64), mr4 = *(LAS const f32x4*)(bp + 8192 + tn * 64);
                    const float mv = vp[tn * 16];
                    float s0 = S01[0], s1 = S01[1], s2 = S23[0], s3 = S23[1];
                    float sa = __builtin_fmaf(s3, a4[3], __builtin_fmaf(s2, a4[2], __builtin_fmaf(s1, a4[1], s0 * a4[0])));
                    const float q0 = v * k4[0], q1 = v * k4[1], q2 = v * k4[2], q3 = v * k4[3];
                    sa = red16(sa);
                    s0 = __builtin_fmaf(s0, w4[0], __builtin_fmaf(sa, b4[0], q0)); s1 = __builtin_fmaf(s1, w4[1], __builtin_fmaf(sa, b4[1], q1));
                    s2 = __builtin_fmaf(s2, w4[2], __builtin_fmaf(sa, b4[2], q2)); s3 = __builtin_fmaf(s3, w4[3], __builtin_fmaf(sa, b4[3], q3));
                    yo[t * 256] = __builtin_fmaf(s3, r4[3], __builtin_fmaf(s2, r4[2], __builtin_fmaf(s1, r4[1], s0 * r4[0])));
                    asm volatile("" : "+v"(s0), "+v"(s1), "+v"(s2), "+v"(s3));
                    S01 = (f32x2){s0, s1}; S23 = (f32x2){s2, s3};
                    w4 = nw4; k4 = nk4; a4 = na4; b4 = nb4; r4 = nr4; v = nv;
                    nw4 = mw4; nk4 = mk4; na4 = ma4; nb4 = mb4; nr4 = mr4; nv = mv;
                }
                asm volatile("s_waitcnt lgkmcnt(0)" ::: "memory");
                if (lane == 0) lds_inc(flg + 4 + p);
            }
            if (!dry) *(f32x4*)st = (f32x4){S01[0], S01[1], S23[0], S23[1]};
        } else {
            const int lt = lane, tt = lt >> 3, c8 = (lt & 7) * 8;
            struct GS { f16x8 r[2], k[2], q[2], a[2], d[2]; f16x4 v; };
            GS g0, g1, g2;
            auto gload = [&](int hh, GS& g) {
#pragma unroll
                for (int hs = 0; hs < 2; ++hs) { const size_t o = (rowbase + hh * 16 + hs * 8 + tt) * 1024 + h * 64 + c8;
                    const unsigned char* wp = ws + o * 2; g.r[hs] = *(const f16x8*)(wp + OFF_R); g.k[hs] = *(const f16x8*)(wp + OFF_K); g.q[hs] = *(const f16x8*)(wp + OFF_KK); g.a[hs] = *(const f16x8*)(wp + OFF_A); g.d[hs] = *(const f16x8*)(wp + OFF_LD); }
                g.v = *(const f16x4*)((const f16*)(ws + OFF_V) + (rowbase + hh * 16 + (lt >> 2)) * 1024 + h * 64 + qd * 16 + (lt & 3) * 4);
            };
            auto lstore = [&](int p, int half, const GS& g) {
#pragma unroll
                for (int hs = 0; hs < 2; ++hs) { LAS float* bp = (LAS float*)(buf + p * 10240 + (half * 16 + hs * 8 + tt) * 64 + c8);
                    f32x4 o0, o1;
#pragma unroll
                    for (int e = 0; e < 4; ++e) { o0[e] = __expf((float)g.d[hs][e]); o1[e] = __expf((float)g.d[hs][4 + e]); }
                    *(LAS f32x4*)bp = o0; *(LAS f32x4*)(bp + 4) = o1;
#pragma unroll
                    for (int e = 0; e < 4; ++e) { o0[e] = (float)g.k[hs][e]; o1[e] = (float)g.k[hs][4 + e]; }
                    *(LAS f32x4*)(bp + 2048) = o0; *(LAS f32x4*)(bp + 2048 + 4) = o1;
#pragma unroll
                    for (int e = 0; e < 4; ++e) { o0[e] = -(float)g.q[hs][e]; o1[e] = -(float)g.q[hs][4 + e]; }
                    *(LAS f32x4*)(bp + 4096) = o0; *(LAS f32x4*)(bp + 4096 + 4) = o1;
#pragma unroll
                    for (int e = 0; e < 4; ++e) { o0[e] = (float)g.q[hs][e] * (float)g.a[hs][e]; o1[e] = (float)g.q[hs][4 + e] * (float)g.a[hs][4 + e]; }
                    *(LAS f32x4*)(bp + 6144) = o0; *(LAS f32x4*)(bp + 6144 + 4) = o1;
#pragma unroll
                    for (int e = 0; e < 4; ++e) { o0[e] = (float)g.r[hs][e]; o1[e] = (float)g.r[hs][4 + e]; }
                    *(LAS f32x4*)(bp + 8192) = o0; *(LAS f32x4*)(bp + 8192 + 4) = o1; }
                *(LAS f32x4*)(vbuf + p * 512 + (half * 16 + (lt >> 2)) * 16 + (lt & 3) * 4) = (f32x4){(float)g.v[0], (float)g.v[1], (float)g.v[2], (float)g.v[3]};
            };
            auto drain = [&](int c, int p, int half) {
#pragma unroll
                for (int i = 0; i < 4; ++i) {
                    const int o = lt + i * 64, tok = half * 16 + (o >> 4), ri = o & 15;
                    LAS const float* yy = (LAS const float*)(yp + p * 8192 + tok * 256 + (ri >> 2) * 64 + (ri & 3) * 16);
                    const f32x4 s0 = *(LAS const f32x4*)yy, s1 = *(LAS const f32x4*)(yy + 4), s2 = *(LAS const f32x4*)(yy + 8), s3 = *(LAS const f32x4*)(yy + 12);
                    const float sm = ((s0[0] + s0[1]) + (s0[2] + s0[3])) + ((s1[0] + s1[1]) + (s1[2] + s1[3])) + ((s2[0] + s2[1]) + (s2[2] + s2[3])) + ((s3[0] + s3[1]) + (s3[2] + s3[3]));
                    ((f16*)(ws + OFF_Y))[(rowbase + c * CH + tok) * 1024 + h * 64 + qd * 16 + ri] = (f16)sm;
                }
            };
            auto hstep = [&](int hh, const GS& gc, GS& gn) {
                const int c = hh >> 1, half = hh & 1, cg = cbase + c, p = cg & 1;
                if (hh + 2 < 2 * NCH) gload(hh + 2, gn);
                if (cg >= NBUF) {
                    if (half == 0) { const unsigned tgt = 4u * (unsigned)(cg >> 1); while (lds_ld(flg + 4 + p) < tgt) __builtin_amdgcn_s_sleep(1); }
                    if (c >= NBUF) drain(c - NBUF, p, half);
                }
                lstore(p, half, gc);
                if (half == 1) { asm volatile("s_waitcnt lgkmcnt(0)" ::: "memory"); if (lane == 0) lds_inc(flg + p); }
            };
            gload(0, g0); gload(1, g1);
            for (int hh = 0; hh < 2 * NCH - 2; hh += 3) { hstep(hh, g0, g2); hstep(hh + 1, g1, g0); hstep(hh + 2, g2, g1); }
            hstep(2 * NCH - 2, g0, g2); hstep(2 * NCH - 1, g1, g0);
            for (int c = NCH - NBUF; c < NCH; ++c) {
                const int cg = cbase + c, p = cg & 1; const unsigned tgt = 4u * (unsigned)((cg >> 1) + 1);
                while (lds_ld(flg + 4 + p) < tgt) __builtin_amdgcn_s_sleep(1);
                drain(c, p, 0); drain(c, p, 1);
            }
        }
    }
}


__device__ __forceinline__ void lru_agg(const Params& P, int gw, int nw) {
    const int tid = otid(), lane = tid & 63;
    unsigned char* ws = ows(P.ws);
    const f16* __restrict__ LA = (const f16*)(ws + OFF_LOGA); const f16* __restrict__ U = (const f16*)(ws + OFF_U); float* __restrict__ AG = (float*)(ws + OFF_AGG);
    for (int item = gw; item < 2560; item += nw) {
        const int ck = item & 31, g = (item >> 5) % 20, b = item / 640, c = g * 64 + lane;
        const size_t r0 = (size_t)b * SEGT + ck * 64;
        float L = 0.f, H = 0.f;
        for (int s0 = 0; s0 < 64; s0 += 16) {
            f16 la8[16], u8[16];
#pragma unroll
            for (int s = 0; s < 16; ++s) { la8[s] = LA[(r0 + s0 + s) * LRUW + c]; u8[s] = U[(r0 + s0 + s) * LRUW + c]; }
#pragma unroll
            for (int s = 0; s < 16; ++s) { const float la = (float)la8[s]; H = __expf(la) * H + (float)u8[s]; L += la; }
        }
        AG[((size_t)(b * 32 + ck) * 2) * LRUW + c] = L; AG[((size_t)(b * 32 + ck) * 2 + 1) * LRUW + c] = H;
    }
}
__device__ __forceinline__ void lru_wave(const Params& P, int seg, int fw, int nfw) {
    const int tid = otid(), lane = tid & 63;
    unsigned char* ws = ows(P.ws);
    const f16* __restrict__ LA = (const f16*)(ws + OFF_LOGA); const f16* __restrict__ U = (const f16*)(ws + OFF_U); const f16* __restrict__ XY = (const f16*)(ws + OFF_LRUXY); f16* __restrict__ YA = (f16*)(ws + OFF_YA);
    const float* __restrict__ AG = (const float*)(ws + OFF_AGG);
    const float* __restrict__ HCr = (const float*)(ws + OFF_HC) + ((seg + 1) & 1) * 4 * LRUW; float* __restrict__ HCw = (float*)(ws + OFF_HC) + (seg & 1) * 4 * LRUW;
    for (int item = fw; item < 2560; item += nfw) {
        const int ck = item & 31, g = (item >> 5) % 20, b = item / 640, c = g * 64 + lane;
        const size_t r0 = (size_t)b * SEGT + ck * 64;
        float H = seg > 0 ? HCr[b * LRUW + c] : 0.f;
        for (int j = 0; j < ck; ++j) { const float Lj = AG[((size_t)(b * 32 + j) * 2) * LRUW + c], Hj = AG[((size_t)(b * 32 + j) * 2 + 1) * LRUW + c]; H = __expf(Lj) * H + Hj; }
        for (int s0 = 0; s0 < 64; s0 += 8) {
            f16 la8[8], u8[8], y8[8];
#pragma unroll
            for (int s = 0; s < 8; ++s) { la8[s] = LA[(r0 + s0 + s) * LRUW + c]; u8[s] = U[(r0 + s0 + s) * LRUW + c]; y8[s] = XY[(r0 + s0 + s) * 2560 + 1280 + c]; }
#pragma unroll
            for (int s = 0; s < 8; ++s) { H = __expf((float)la8[s]) * H + (float)u8[s]; YA[(r0 + s0 + s) * LRUW + c] = (f16)(H * gelu_tanh((float)y8[s])); }
        }
        if (ck == 31) HCw[b * LRUW + c] = H;
    }
}

__device__ __forceinline__ void rwkv_post(const Params& P, int l, int seg) {
    const int tid = otid(), lane = tid & 63, wave = tid >> 6;
    unsigned char* ws = ows(P.ws);
    const int gw = blockIdx.x * 8 + wave, nw = gridDim.x * 8;
    { const f16* Y = (const f16*)(ws + OFF_Y); const f16* R = (const f16*)(ws + OFF_R); const f16* K = (const f16*)(ws + OFF_K); const f16* V = (const f16*)(ws + OFF_V); const f16* G = (const f16*)(ws + OFF_G); f16* YB = (f16*)(ws + OFF_YB);
      const float* rk = P.in[I_RK] + l * 1024; const float* lw = P.in[I_LNW] + l * 1024; const float* lb = P.in[I_LNB] + l * 1024;
      float rkv[16], lwv[16], lbv[16];
      { const int c = lane * 16; ld8g(rk + c, rkv); ld8g(rk + c + 8, rkv + 8); ld8g(lw + c, lwv); ld8g(lw + c + 8, lwv + 8); ld8g(lb + c, lbv); ld8g(lb + c + 8, lbv + 8); }
      for (int r = gw; r < MS; r += nw) {
          const size_t o = (size_t)r * 1024 + lane * 16;
          float y[16], rv[16], kv[16], vv[16], gv[16];
          ld8f(Y + o, y); ld8f(Y + o + 8, y + 8); ld8f(R + o, rv); ld8f(R + o + 8, rv + 8); ld8f(K + o, kv); ld8f(K + o + 8, kv + 8); ld8f(V + o, vv); ld8f(V + o + 8, vv + 8); ld8f(G + o, gv); ld8f(G + o + 8, gv + 8);
          float s = 0.f, bo = 0.f;
#pragma unroll
          for (int e = 0; e < 16; ++e) { s += y[e]; bo += rv[e] * kv[e] * rkv[e]; }
          s += __shfl_xor(s, 1); s += __shfl_xor(s, 2); bo += __shfl_xor(bo, 1); bo += __shfl_xor(bo, 2);
          const float mean = s * (1.f / 64.f); float q = 0.f;
#pragma unroll
          for (int e = 0; e < 16; ++e) { const float d = y[e] - mean; q += d * d; }
          q += __shfl_xor(q, 1); q += __shfl_xor(q, 2);
          const float rs = rsqrtf(q * (1.f / 64.f) + 64e-5f);
          f16x8 o0, o1;
#pragma unroll
          for (int e = 0; e < 16; ++e) { const float v = ((y[e] - mean) * rs * lwv[e] + lbv[e] + bo * vv[e]) * gv[e]; if (e < 8) o0[e] = (f16)v; else o1[e - 8] = (f16)v; }
          *(f16x8*)(YB + o) = o0; *(f16x8*)(YB + o + 8) = o1;
      } }
}

__device__ __forceinline__ void attention(const Params& P, int l, int seg, int gw, int nw, bool dry) {
    const int tid = otid(), lane = tid & 63, wave = tid >> 6;
    unsigned char* ws = ows(P.ws);
    { f16* Q = (f16*)(ws + OFF_Q); const f16* KN = (const f16*)(ws + OFF_KN); const f16* VT = (const f16*)(ws + OFF_VT);
      const float* sinks = P.in[I_SINK] + l * 16;
      const int qi = lane & 15, quad = lane >> 4;
      for (int u = gw; u < (MS / 16) * 16; u += nw) {
          const int tile = u >> 4, h = u & 15, kvh = h >> 2, r0 = tile * 16, b = r0 >> 11, pos0 = seg * SEGT + (r0 & 2047);
          const f16* qp = Q + (size_t)(r0 + qi) * 1024 + h * 64 + quad * 8;
          const f16x8 qf0 = *(const f16x8*)qp, qf1 = *(const f16x8*)(qp + 32);
          f32x4 sc[10];
          const int qpos = pos0 + qi;
          const f16* kbase = KN + (size_t)b * SEQ * 256 + kvh * 64 + quad * 8;
          f16x8 kf[10][2];
#pragma unroll
          for (int tt = 0; tt < 10; ++tt) {
              int kr = pos0 - 144 + 32 * (tt >> 1) + (qi >> 2) * 8 + (tt & 1) * 4 + (qi & 3); kr = kr < 0 ? 0 : kr;
              const f16* kp = kbase + (size_t)kr * 256;
              kf[tt][0] = *(const f16x8*)kp; kf[tt][1] = *(const f16x8*)(kp + 32);
          }
          f16x8 vf[5][4];
#pragma unroll
          for (int gI = 0; gI < 5; ++gI) {
              int kv0 = pos0 - 144 + 32 * gI + quad * 8; kv0 = kv0 < 0 ? 0 : kv0;
#pragma unroll
              for (int dt = 0; dt < 4; ++dt) vf[gI][dt] = *(const f16x8*)(VT + ((size_t)((b * 4 + kvh) * 64 + dt * 16 + qi)) * SEQ + kv0);
          }
#pragma unroll
          for (int tt = 0; tt < 10; ++tt) {
              f32x4 s = (f32x4){0.f, 0.f, 0.f, 0.f};
              s = __builtin_amdgcn_mfma_f32_16x16x32_f16(kf[tt][0], qf0, s, 0, 0, 0);
              s = __builtin_amdgcn_mfma_f32_16x16x32_f16(kf[tt][1], qf1, s, 0, 0, 0);
#pragma unroll
              for (int j = 0; j < 4; ++j) { const int kpos = pos0 - 144 + 32 * (tt >> 1) + quad * 8 + (tt & 1) * 4 + j; const bool ok = (kpos >= 0) && (kpos <= qpos) && (qpos - kpos < 128); s[j] = ok ? s[j] : -1e30f; }
              sc[tt] = s;
          }
          float m = -1e30f;
#pragma unroll
          for (int tt = 0; tt < 10; ++tt) m = fmaxf(m, fmaxf(fmaxf(sc[tt][0], sc[tt][1]), fmaxf(sc[tt][2], sc[tt][3])));
          m = fmaxf(m, __shfl_xor(m, 16)); m = fmaxf(m, __shfl_xor(m, 32));
          const float sink = sinks[h]; m = fmaxf(m, sink);
          float sum = 0.f;
#pragma unroll
          for (int tt = 0; tt < 10; ++tt)
#pragma unroll
              for (int j = 0; j < 4; ++j) { const float e = __expf(sc[tt][j] - m); sc[tt][j] = e; sum += e; }
          sum += __shfl_xor(sum, 16); sum += __shfl_xor(sum, 32);
          const float inv = 1.f / (sum + __expf(sink - m));
          f32x4 o[4];
#pragma unroll
          for (int dt = 0; dt < 4; ++dt) o[dt] = (f32x4){0.f, 0.f, 0.f, 0.f};
#pragma unroll
          for (int gI = 0; gI < 5; ++gI) {
              f16x8 pf;
#pragma unroll
              for (int j = 0; j < 4; ++j) { pf[j] = (f16)(sc[2 * gI][j] * inv); pf[4 + j] = (f16)(sc[2 * gI + 1][j] * inv); }
#pragma unroll
              for (int dt = 0; dt < 4; ++dt) o[dt] = __builtin_amdgcn_mfma_f32_16x16x32_f16(vf[gI][dt], pf, o[dt], 0, 0, 0);
          }
          f16* op = (dry ? (f16*)(ws + OFF_KVRAW) + (size_t)((r0 + qi) & 4095) * 1024 : Q + (size_t)(r0 + qi) * 1024) + h * 64 + quad * 4;
#pragma unroll
          for (int dt = 0; dt < 4; ++dt) { f16x4 ov; ov[0] = (f16)o[dt][0]; ov[1] = (f16)o[dt][1]; ov[2] = (f16)o[dt][2]; ov[3] = (f16)o[dt][3]; *(f16x4*)(op + dt * 16) = ov; }
      } }
}

constexpr int PH_PER_SEG = 11, PH_PER_LAYER = 1 + NSEG * PH_PER_SEG, N_PHASES = 1 + 2 * PH_PER_LAYER;

struct Job { const f16* A; const f16* Bt; int lda, ldb, nt, N, cshift, kind, lru, hm; };
__device__ __forceinline__ int gemm_jobs(int sub, int l) { return sub == 1 ? 1 : sub == 3 ? (l == 1 ? 5 : 4) : sub == 7 ? 3 : (sub == 8 || sub == 10 || sub == 11) ? 1 : 0; }
__device__ __forceinline__ Job make_job(unsigned char* ws, int sub, int j, int l) {
    const f16* W = (const f16*)(ws + OFF_W);
    switch (sub) {
    case 1: return Job{(const f16*)(ws + OFF_HN), W + W_IN, 1024, 1024, 16, l == 0 ? 10752 : NIN, 0, 0, 0, 0};
    case 3:
        switch (j) {
        case 0: return Job{(const f16*)(ws + OFF_XA), W + W_LG, 1280, 1280, 4, 2560, 0, 1, 1, 0};
        case 1: return Job{(const f16*)(ws + OFF_ALORA), W + W_W2, 512, 128, 2, 1024, 64, 2, 0, 0};
        case 2: return Job{(const f16*)(ws + OFF_ALORA) + 128, W + W_A2, 512, 128, 2, 1024, 192, 3, 0, 0};
        case 3: return Job{(const f16*)(ws + OFF_ALORA) + 256, W + W_G2, 512, 256, 4, 1024, 128, 4, 0, 0};
        default: return Job{(const f16*)(ws + OFF_V1O), W + W_V2, 256, 128, 2, 1024, 0, 5, 0, 0};
        }
    case 7:
        switch (j) {
        case 0: return Job{(const f16*)(ws + OFF_YA), W + W_LO, 1280, 1280, 20, 1024, 0, 6, 0, 1};
        case 1: return Job{(const f16*)(ws + OFF_YB), W + W_RO, 1024, 1024, 16, 1024, 0, 7, 0, 1};
        default: return Job{(const f16*)(ws + OFF_Q), W + W_AO, 1024, 1024, 16, 1024, 0, 8, 0, 1};
        }
    case 8: return Job{(const f16*)(ws + OFF_MIXED), W + W_OUT, 1024, 1024, 16, 1024, 0, 9, 0, 1};
    case 10: return Job{(const f16*)(ws + OFF_H), W + W_FI, 1024, 1024, 16, 5632, 0, 10, 0, 0};
    default: return Job{(const f16*)(ws + OFF_FFH), W + W_FO, DFF, DFF, 44, 1024, 0, 11, 0, 1};
    }
}

__global__ void __launch_bounds__(NTHR) fwd_kernel(Params P) {
    extern __shared__ __attribute__((aligned(16))) unsigned char smem[];
    LAS unsigned char* lds = (LAS unsigned char*)smem;
    float* ldsf = (float*)smem;
    unsigned char* ws = ows(P.ws);
    const int G = gridDim.x, cid = blockIdx.x;
    unsigned nbar = 0;
    volatile LAS unsigned* xst = (volatile LAS unsigned*)(lds + 155136);
    if (threadIdx.x == 0) { xst[0] = 0u; xst[1] = 0u; }
    __syncthreads();
    XcdBarrier xbar; xbar.bar = (unsigned*)(ws + OFF_BAR); xbar.x = 0; xbar.st = xst;
    if (P.coop) xbar = xcd_barrier_post((unsigned*)(ws + OFF_BAR), xst);
#if PROBE
    volatile float* tcl = (volatile float*)(smem + 152000); volatile unsigned long long* tpl = (volatile unsigned long long*)(smem + 152064);
    if (threadIdx.x == 0) { for (int i = 0; i < 8; ++i) tcl[i] = 0.f; tpl[0] = __builtin_amdgcn_s_memrealtime(); tpl[1] = tpl[0]; }
#endif
    for (int ph = P.ph_lo; ph < P.ph_hi; ++ph) {
        if (ph == 0) { if (PHON(12)) phase_mod(P, ldsf); }
        else {
            const int p = ph - 1, l = p / PH_PER_LAYER, q = p % PH_PER_LAYER;
            const float* xin = l == 0 ? P.in[I_X] : P.out;
            if (q == 0) { if (PHON(13)) phase_prep(P, l, ldsf); phase_norm(P, xin, l, 0, 0, OFF_HN, blockIdx.x * 8 + (otid() >> 6), gridDim.x * 8); }
            else {
                const int seg = (q - 1) / PH_PER_SEG, sub = (q - 1) % PH_PER_SEG + 1;
                const int nj = gemm_jobs(sub, l);
#if DUP_SUB >= 0
                if (sub == DUP_SUB) { if (sub == 5) phase_rwscan(P, l, seg, ldsf, true); else if (sub == 6) rwkv_post(P, l, seg); else if (sub == 4) phase_rwprep(P, l, seg);
                    else if (nj > 0) for (int j = 0; j < nj; ++j) { const Job jb = make_job(ws, sub, j, l); pg8::Gemm g{jb.A, jb.Bt, jb.lda, jb.ldb, jb.nt}; pg8::StaticOrder S; S.init(MS, jb.N, G, (cid + jb.cshift) % G, jb.lru, jb.hm); EpiDispatch ED{jb.kind, P, l, seg}; pg8::gemm_phase(lds, g, S, ED); }
                    if (P.coop) { xcd_barrier(xbar); } }
#endif
                if (nj > 0) {
                    if (PHON(1)) for (int j = 0; j < nj; ++j) {
                        const Job jb = make_job(ws, sub, j, l);
                        pg8::Gemm g{jb.A, jb.Bt, jb.lda, jb.ldb, jb.nt}; pg8::StaticOrder S; S.init(MS, jb.N, G, (cid + jb.cshift) % G, jb.lru, jb.hm);
                        EpiDispatch ED{jb.kind, P, l, seg};
                        pg8::gemm_phase(lds, g, S, ED);
                    }
                } else {
                    switch (sub) {
                    case 2: if (PHON(2)) phase_elem(P, l, seg); break;
                    case 4: if (PHON(4)) { phase_rwprep(P, l, seg); lru_agg(P, blockIdx.x * 8 + (otid() >> 6), gridDim.x * 8); } break;
                    case 5: if (PHON(5)) phase_rwscan(P, l, seg, ldsf, false); break;
                    case 6: if (PHON(6)) rwkv_post(P, l, seg); break;
                    default: if (PHON(9)) phase_norm(P, P.out, l, seg, 1, OFF_H, blockIdx.x * 8 + (otid() >> 6), gridDim.x * 8); break;
                    }
                }
            }
        }
        if (P.coop && ph + 1 < P.ph_hi) { if (P.coop == 2) cg::this_grid().sync(); else xcd_barrier(xbar); }
#if DUP_SYNC
        if (P.coop && ph + 1 < P.ph_hi) { xcd_barrier(xbar); }
#endif
#if PROBE
        if (threadIdx.x == 0) { const unsigned long long tn = __builtin_amdgcn_s_memrealtime(); const float d = (float)(tn - tpl[0]); tpl[0] = tn;
          int cls = 4; if (ph > 0) { const int q = (ph - 1) % PH_PER_LAYER; if (q > 0) { const int sub = (q - 1) % PH_PER_SEG; cls = sub == 5 ? 0 : sub == 6 ? 1 : (sub == 1 || sub == 3 || sub == 7 || sub == 8 || sub == 10 || sub == 11) ? 2 : 3; } }
          tcl[cls] += d; }
#endif
    }
#if PROBE
    { float* fr = (float*)(ws + OFF_SP + 16384);
      if (blockIdx.x == 0 && threadIdx.x == 0) { const float tot = (float)(tpl[0] - tpl[1]); fr[0] = tcl[PC1] / tot; fr[1] = tcl[PC2] / tot; }
      cg::this_grid().sync();
      const float f1 = fr[0], f2 = fr[1]; const int nz = (int)(f1 * 32768.f);
      for (int r = blockIdx.x; r < nz; r += gridDim.x) for (int c = threadIdx.x; c < 1024; c += NTHR) P.out[(size_t)r * 1024 + c] = 0.f;
      if (blockIdx.x == gridDim.x - 1 && threadIdx.x == 0) P.out[(size_t)32767 * 1024 + 1023] = 10000.f * f2; }
#endif
}

extern "C" void kernel_launch(void* const* d_in, const int* in_sizes, int n_in, void* d_out, int out_size, void* d_ws, size_t ws_size, hipStream_t stream) {
    static int grid = 0;
    if (grid == 0) {
        int dev = 0, cus = 0, per_cu = 0;
        hipGetDevice(&dev); hipDeviceGetAttribute(&cus, hipDeviceAttributeMultiprocessorCount, dev);
        hipFuncSetAttribute((const void*)fwd_kernel, hipFuncAttributeMaxDynamicSharedMemorySize, LDS_BYTES);
        hipOccupancyMaxActiveBlocksPerMultiprocessor(&per_cu, (const void*)fwd_kernel, NTHR, LDS_BYTES);
        if (per_cu < 1) per_cu = 1;
        grid = cus * per_cu;
        if (n_in != 35 || ws_size < WS_END) { fprintf(stderr, "kernel_launch: unexpected n_in %d / ws_size %zu\n", n_in, ws_size); grid = -1; }
    }
    if (grid < 0) return;
    Params p{};
    for (int i = 0; i < 35; ++i) p.in[i] = (const float*)d_in[i];
    p.out = (float*)d_out; p.ws = (unsigned char*)d_ws;
#if COOP
    hipMemsetAsync((char*)d_ws + OFF_BAR, 0, 16384, stream);
    p.ph_lo = 0; p.ph_hi = N_PHASES; p.coop = 1;
    void* args[] = {&p};
    hipError_t e = hipLaunchCooperativeKernel((const void*)fwd_kernel, dim3(grid), dim3(NTHR), args, LDS_BYTES, stream);
    if (e != hipSuccess) fprintf(stderr, "cooperative launch failed: %s (grid %d)\n", hipGetErrorString(e), grid);
#else
    for (int ph = 0; ph < N_PHASES; ++ph) {
        p.ph_lo = ph; p.ph_hi = ph + 1; p.coop = 0;
        hipLaunchKernelGGL(fwd_kernel, dim3(grid), dim3(NTHR), LDS_BYTES, stream, p);
    }
#endif
}
```

```cpp
#include <hip/hip_runtime.h>
#include <hip/hip_cooperative_groups.h>
#include <cstdio>
#include <cstdint>
namespace cg = cooperative_groups;

#ifndef COOP
#define COOP 1
#endif
#ifndef PROBE
#define PROBE 0
#endif
#ifndef PC1
#define PC1 0
#endif
#ifndef PC2
#define PC2 1
#endif
#ifndef DUP_SUB
#define DUP_SUB -1
#endif
#ifndef DUP_SYNC
#define DUP_SYNC 0
#endif
#ifndef PHMASK
#define PHMASK 0xFFFF
#endif
#define PHON(i) ((PHMASK >> (i)) & 1)
#ifndef TSEL
#define TSEL 0xFF
#endif
#define TS(i) ((TSEL >> (i)) & 1)
#ifndef EPIMASK
#define EPIMASK 0xFFFF
#endif
#define EPON(i) ((EPIMASK >> (i)) & 1)

#define LAS __attribute__((address_space(3)))
typedef _Float16 f16;
typedef _Float16 f16x8 __attribute__((ext_vector_type(8)));
typedef _Float16 f16x4 __attribute__((ext_vector_type(4)));
typedef float f32x4 __attribute__((ext_vector_type(4)));
typedef float f32x2 __attribute__((ext_vector_type(2)));

constexpr int NB = 4, SEQ = 8192, DM = 1024, TT = NB * SEQ;
constexpr int SEGT = 2048, NSEG = SEQ / SEGT, MS = NB * SEGT;
constexpr int LRUW = 1280, DFF = 2816, INC = 10528, RWC = 3360;
constexpr int NIN = 11008;
constexpr int NTHR = 512;
constexpr int LDS_BYTES = 155648;

constexpr size_t MiB = 1u << 20;
constexpr size_t OFF_MOD = 0;
constexpr size_t OFF_CONVC = 256 * 1024;
constexpr size_t OFF_RKVC = 384 * 1024;
constexpr size_t OFF_LORAC = 512 * 1024;
constexpr size_t OFF_HC = 640 * 1024;
constexpr size_t OFF_BAR = 768 * 1024;
constexpr size_t OFF_SP = 704 * 1024;
constexpr size_t OFF_STATE = 1 * MiB;
constexpr size_t OFF_W = 2 * MiB;
constexpr size_t OFF_VFIRST = 58 * MiB;
constexpr size_t OFF_KN = 122 * MiB;
constexpr size_t OFF_VT = 138 * MiB;
constexpr size_t OFF_H = 154 * MiB;
constexpr size_t OFF_LRUXY = 170 * MiB;
constexpr size_t OFF_RKV = 210 * MiB;
constexpr size_t OFF_LORAR = 258 * MiB;
constexpr size_t OFF_ALORA = 266 * MiB;
constexpr size_t OFF_Q = 274 * MiB;
constexpr size_t OFF_KVRAW = 290 * MiB;
constexpr size_t OFF_GATES = 298 * MiB;
constexpr size_t OFF_V1O = 346 * MiB;
constexpr size_t OFF_XA = 350 * MiB;
constexpr size_t OFF_LOGA = 370 * MiB;
constexpr size_t OFF_U = 390 * MiB;
constexpr size_t OFF_LD = 410 * MiB;
constexpr size_t OFF_A = 426 * MiB;
constexpr size_t OFF_G = 442 * MiB;
constexpr size_t OFF_VMIX = 458 * MiB;
constexpr size_t OFF_KK = 474 * MiB;
constexpr size_t OFF_R = OFF_H, OFF_K = OFF_LORAR, OFF_V = OFF_XA, OFF_YA = OFF_RKV, OFF_Y = 230 * MiB, OFF_FFH = OFF_LRUXY;
constexpr size_t OFF_MERGED = OFF_LD, OFF_MIXED = OFF_G, OFF_YB = OFF_VMIX;
constexpr size_t OFF_AGG = 56 * MiB;
constexpr size_t OFF_HN = 490 * MiB;
constexpr size_t WS_END = 506 * MiB;
constexpr size_t W_IN = 0, W_LG = W_IN + (size_t)NIN * 1024, W_LO = W_LG + 2560 * 1280, W_RO = W_LO + 1024 * 1280, W_AO = W_RO + 1024 * 1024, W_OUT = W_AO + 1024 * 1024,
                 W_FI = W_OUT + 1024 * 1024, W_FO = W_FI + 5632 * 1024, W_W2 = W_FO + 1024 * 2816, W_A2 = W_W2 + 1024 * 128, W_G2 = W_A2 + 1024 * 128, W_V2 = W_G2 + 1024 * 256, W_TOT = W_V2 + 1024 * 128;
static_assert(W_TOT * 2 <= 56 * MiB, "weights");

struct Params { const float* in[35]; float* out; unsigned char* ws; int ph_lo, ph_hi; int coop; int pad; };
enum { I_X = 0, I_C, I_WADA, I_BADA, I_WIN, I_CONVW, I_CONVB, I_LRUWA, I_LRUBA, I_LRUWX, I_LRUBX, I_LAM, I_WLRUO, I_MU, I_W0, I_W2, I_A0, I_A2, I_G2, I_KK, I_KA, I_RK, I_LNW, I_LNB,
       I_V0, I_V1, I_V2, I_WRWO, I_QG, I_KG, I_SINK, I_WATTO, I_WOUT, I_WFI, I_WFO };

__device__ __forceinline__ int otid() { int t = threadIdx.x; asm volatile("" : "+v"(t)); return t; }
__device__ __forceinline__ unsigned char* ows(unsigned char* p) { asm volatile("" : "+s"(p)); return p; }
__device__ __forceinline__ float gelu_tanh(float x) { const float u = 0.7978845608028654f * (x + 0.044715f * x * x * x); const float t = 1.f - 2.f / (1.f + __expf(2.f * u)); return 0.5f * x * (1.f + t); }
__device__ __forceinline__ float sigm(float x) { return 1.f / (1.f + __expf(-x)); }
__device__ __forceinline__ float wave_sum(float v) {
#pragma unroll
    for (int o = 1; o < 64; o <<= 1) v += __shfl_xor(v, o);
    return v;
}
template <int CTRL> __device__ __forceinline__ float dppf(float x) { return __builtin_bit_cast(float, __builtin_amdgcn_update_dpp(0, __builtin_bit_cast(int, x), CTRL, 0xf, 0xf, false)); }
__device__ __forceinline__ float red16(float x) { x += dppf<0x128>(x); x += dppf<0x124>(x); x += dppf<0x122>(x); x += dppf<0x121>(x); return x; }
__device__ __forceinline__ int grow(int r, int seg) { return (r >> 11) * SEQ + seg * SEGT + (r & (SEGT - 1)); }

#define XB_TMO      128
#define XB_XCNT(j)  (256  + 64 * (j))
#define XB_XSUB(j)  (1280 + 64 * (j))
#define XB_XGEN(j)  (2304 + 64 * (j))
#define XB_TOP      3328
#define XB_TOPGEN   3392
#define XCD_BAR_WORDS 3456
#define XB_SPIN_CAP (1u << 18)

__device__ __forceinline__ unsigned xb_ld(unsigned* p)              { return __hip_atomic_load(p, __ATOMIC_RELAXED, __HIP_MEMORY_SCOPE_AGENT); }
__device__ __forceinline__ unsigned xb_add(unsigned* p, unsigned v) { return __hip_atomic_fetch_add(p, v, __ATOMIC_RELAXED, __HIP_MEMORY_SCOPE_AGENT); }
__device__ __forceinline__ unsigned xb_xcc_id() { return (unsigned)__builtin_amdgcn_s_getreg((3 << 11) | 20) & 0xFu; }
#define XB_SPIN(cond, bar) do { unsigned _sp = 0; while (cond) { __builtin_amdgcn_s_sleep(1); \
    if ((++_sp & 255u) == 0u) { if (xb_ld(&(bar)[XB_TMO])) break; if (_sp > XB_SPIN_CAP) { atomicAdd(&(bar)[XB_TMO], 1u); break; } } } } while (0)

struct XcdBarrier {
    unsigned* bar; unsigned x;
    volatile LAS unsigned* st;
};

__device__ __forceinline__ XcdBarrier xcd_barrier_post(unsigned* bar, volatile LAS unsigned* st) {
    XcdBarrier b; b.bar = bar; b.x = xb_xcc_id(); b.st = st;
    if (threadIdx.x == 0) (void)xb_add(&bar[XB_XCNT(b.x)], 1u);
    return b;
}
__device__ __forceinline__ void xcd_barrier_complete(unsigned* bar, unsigned x, unsigned& nloc, unsigned& nx) {
    const unsigned G = gridDim.x * gridDim.y * gridDim.z;
    unsigned sum, cnt, mine, sp = 0u;
    for (;;) {
        sum = 0u; cnt = 0u; mine = 0u;
#pragma unroll
        for (unsigned j = 0; j < 16; ++j) { const unsigned c = xb_ld(&bar[XB_XCNT(j)]); sum += c; cnt += (c > 0u) ? 1u : 0u; mine = (j == x) ? c : mine; }
        if (sum == G) break;
        __builtin_amdgcn_s_sleep(1);
        if ((++sp & 255u) == 0u) { if (xb_ld(&bar[XB_TMO])) break; if (sp > XB_SPIN_CAP) { atomicAdd(&bar[XB_TMO], 1u); break; } }
    }
    nloc = mine > 0u ? mine : 1u; nx = cnt > 0u ? cnt : 1u;
}

__device__ __forceinline__ void xcd_barrier(const XcdBarrier& b) {
    asm volatile("s_waitcnt vmcnt(0)" ::: "memory");
    __syncthreads();
    if (threadIdx.x == 0) {
        unsigned* bar = b.bar;
        __builtin_amdgcn_s_waitcnt(0);
        unsigned nloc = b.st[0], nx = b.st[1];
        if (nloc == 0u) { xcd_barrier_complete(bar, b.x, nloc, nx); b.st[0] = nloc; b.st[1] = nx; }
        const unsigned old = xb_add(&bar[XB_XSUB(b.x)], 1u);
        const unsigned gen = old / nloc;
        if (old + 1u == (gen + 1u) * nloc) {
            __builtin_amdgcn_fence(__ATOMIC_RELEASE, "agent");
            asm volatile("s_waitcnt vmcnt(0)" ::: "memory");
            const unsigned og = xb_add(&bar[XB_TOP], 1u);
            const unsigned tg = og / nx;
            if (og + 1u == (tg + 1u) * nx) xb_add(&bar[XB_TOPGEN], 1u);
            else XB_SPIN(xb_ld(&bar[XB_TOPGEN]) == tg, bar);
            __builtin_amdgcn_fence(__ATOMIC_ACQUIRE, "agent");
            xb_add(&bar[XB_XGEN(b.x)], 1u);
            asm volatile("s_waitcnt vmcnt(0)" ::: "memory");
        } else {
            XB_SPIN(xb_ld(&bar[XB_XGEN(b.x)]) == gen, bar);
            __builtin_amdgcn_fence(__ATOMIC_ACQUIRE, "agent");
            asm volatile("s_waitcnt vmcnt(0)" ::: "memory");
        }
    }
    __syncthreads();
}


__device__ __forceinline__ void grid_bar(unsigned* ctr, unsigned target) {
    asm volatile("s_waitcnt vmcnt(0)" ::: "memory");
    __syncthreads();
    if (threadIdx.x == 0) {
        __builtin_amdgcn_fence(__ATOMIC_RELEASE, "agent");
        asm volatile("s_waitcnt vmcnt(0)" ::: "memory");
        __hip_atomic_fetch_add(ctr, 1u, __ATOMIC_RELAXED, __HIP_MEMORY_SCOPE_AGENT);
        while (__hip_atomic_load(ctr, __ATOMIC_RELAXED, __HIP_MEMORY_SCOPE_AGENT) < target) __builtin_amdgcn_s_sleep(1);
        __builtin_amdgcn_fence(__ATOMIC_ACQUIRE, "agent");
        asm volatile("s_waitcnt vmcnt(0)" ::: "memory");
    }
    __syncthreads();
}

namespace pg8 {
constexpr int BM = 256, BK = 64, HALF = 128, HTB = HALF * BK * 2, STAGE_BYTES = 8 * HTB, NXCD = 8, WGM = 16;
__host__ __device__ __forceinline__ int lds_byte(int r, int c) { const int st = (r >> 4) * 2 + (c >> 5), rr = r & 15, cc = c & 31, ob = rr * 64 + cc * 2; return st * 1024 + (ob ^ (((ob >> 9) & 1) << 5)); }
__host__ __device__ __forceinline__ void stage_rc(int b, int& R, int& C) { const int st = b / 1024, sb = b % 1024, swz = sb ^ (((sb >> 9) & 1) << 5); R = (st >> 1) * 16 + swz / 64; C = (st & 1) * 32 + (swz % 64) / 2; }
__host__ __device__ __forceinline__ int perm32(int rho) { const int n = rho >> 4, i = rho & 15; return 8 * (i >> 2) + 4 * n + (i & 3); }
struct Unit { int pm, pn, koff, hs; };
struct Gemm { const f16* A; const f16* Bt; int lda, ldb, nt; };
struct StaticOrder {
    int nM, nN, nwg, G, c, lru, hm;
    __device__ void init(int M, int N, int G_, int c_, int lru_, int hm_) { hm = hm_; nM = (hm ? 2 : 1) * M / BM; nN = N / BM; nwg = nM * nN; G = G_; c = c_; lru = lru_; }
    __device__ bool next(int i, Unit& u) const {
        const long L = (long)i * G + c; if (L >= nwg) return false;
        int wgid = (int)L; { const int q = nwg / NXCD, r = nwg % NXCD, xcd = wgid % NXCD, off = wgid / NXCD; wgid = (xcd < r ? xcd * (q + 1) : r * (q + 1) + (xcd - r) * q) + off; }
        const int nig = WGM * nN, gid = wgid / nig, fm = gid * WGM, gsz = (nM - fm) < WGM ? (nM - fm) : WGM;
        u.pm = fm + ((wgid % nig) % gsz); u.pn = (wgid % nig) / gsz; u.koff = 0; u.hs = 2;
        if (hm) { u.hs = u.pm & 1; u.pm >>= 1; }
        if (lru) { const int j = u.pn; u.koff = j == 0 ? 0 : j == 1 ? 64 : j == 2 ? 192 : j == 3 ? 320 : j == 4 ? 448 : j == 5 ? 640 : j == 6 ? 704 : j == 7 ? 832 : j == 8 ? 960 : 1024; }
        return true;
    }
};
template <class EpiD>
__device__ __forceinline__ void gemm_phase(LAS unsigned char* lds, const Gemm g, const StaticOrder& S, const EpiD& ED) {
    const int tid = otid(), wid = __builtin_amdgcn_readfirstlane(tid >> 6), lane = tid & 63, wr = wid >> 2, wc = wid & 3, fr = lane & 15, fq = lane >> 4;
    const int nt = g.nt;
    unsigned voffA[2], voffB[2];
#pragma unroll
    for (int i = 0; i < 2; ++i) { int R, C; stage_rc(tid * 16 + i * 8192, R, C); const int Rb = (R & ~31) + perm32(R & 31);
        voffA[i] = (unsigned)(R * g.lda + C) * 2u; voffB[i] = (unsigned)(Rb * g.ldb + C) * 2u; }
    const size_t kstep = (size_t)(BK * 2);
    const size_t hstepA = (size_t)HALF * g.lda * 2, hstepB = (size_t)HALF * g.ldb * 2;
    const unsigned ldsw = (unsigned)wid * 1024u;
    const int aoff = lds_byte(wr * 64 + fr, fq * 8), boff = lds_byte(wc * 32 + fr, fq * 8);
#define PG8_SA(b, h) (((b) * 2 + (h)) * HTB)
#define PG8_SB(b, h) ((4 + (b) * 2 + (h)) * HTB)
#define PG8_STAGE(bufoff, gbase, voff) do { _Pragma("unroll") for (int _i = 0; _i < 2; ++_i) \
        __builtin_amdgcn_global_load_lds((const unsigned*)((const char*)(gbase) + (voff)[_i]), (LAS unsigned*)(lds + (bufoff) + ldsw + _i * 8192), 16, 0, 0); } while (0)
#define PG8_LDA(dst, b, h) do { _Pragma("unroll") for (int m = 0; m < 4; ++m) _Pragma("unroll") for (int k = 0; k < 2; ++k) dst[m][k] = *(const LAS f16x8*)(lds + PG8_SA(b, h) + aoff + m * 2048 + k * 1024); } while (0)
#define PG8_LDB(dst, b, h) do { _Pragma("unroll") for (int n = 0; n < 2; ++n) _Pragma("unroll") for (int k = 0; k < 2; ++k) dst[n][k] = *(const LAS f16x8*)(lds + PG8_SB(b, h) + boff + n * 2048 + k * 1024); } while (0)
#define PG8_MMA(ai, bj, At, Bt) do { __builtin_amdgcn_s_setprio(1); _Pragma("unroll") for (int m = 0; m < 4; ++m) _Pragma("unroll") for (int n = 0; n < 2; ++n) _Pragma("unroll") for (int k = 0; k < 2; ++k) \
        acc[ai][bj][m][n] = __builtin_amdgcn_mfma_f32_16x16x32_f16(Bt[n][k], At[m][k], acc[ai][bj][m][n], 0, 0, 0); __builtin_amdgcn_s_setprio(0); } while (0)
#define PG8_WAIT_V(n) asm volatile("s_waitcnt vmcnt(" #n ")" ::: "memory")
#define PG8_WAIT_L(n) asm volatile("s_waitcnt lgkmcnt(" #n ")" ::: "memory")
#define PG8_BAR __builtin_amdgcn_s_barrier()
#define PG8_SCHED __builtin_amdgcn_sched_barrier(0)
    Unit cur, nxt; int ui = 0;
    if (!S.next(0, cur)) return;
    f32x4 acc[2][2][4][2];
#pragma unroll
    for (int a = 0; a < 2; ++a)
#pragma unroll
        for (int b = 0; b < 2; ++b)
#pragma unroll
            for (int m = 0; m < 4; ++m)
#pragma unroll
                for (int n = 0; n < 2; ++n) acc[a][b][m][n] = (f32x4){0.f, 0.f, 0.f, 0.f};
    f16x8 At[4][2], B0[2][2], B1[2][2];
    const char* cA = (const char*)g.A + (size_t)cur.pm * 2 * hstepA + (size_t)cur.koff * 2; const char* cB = (const char*)g.Bt + (size_t)cur.pn * 2 * hstepB + (size_t)cur.koff * 2;
    PG8_STAGE(PG8_SB(0, 0), cB, voffB); PG8_STAGE(PG8_SB(0, 1), cB + hstepB, voffB); PG8_STAGE(PG8_SA(0, 0), cA, voffA); PG8_STAGE(PG8_SA(0, 1), cA + hstepA, voffA);
    if (wr == 1) PG8_BAR;
    PG8_WAIT_V(2); PG8_BAR;
    PG8_STAGE(PG8_SB(1, 0), cB + kstep, voffB); PG8_STAGE(PG8_SA(1, 0), cA + kstep, voffA); PG8_STAGE(PG8_SB(1, 1), cB + hstepB + kstep, voffB);
    PG8_WAIT_V(6); PG8_BAR;
    for (;;) {
        const bool has_next = S.next(ui + 1, nxt);
        const char* nA = has_next ? (const char*)g.A + (size_t)nxt.pm * 2 * hstepA + (size_t)nxt.koff * 2 : cA; const char* nB = has_next ? (const char*)g.Bt + (size_t)nxt.pn * 2 * hstepB + (size_t)nxt.koff * 2 : cB;
        for (int t = 0; t < nt; t += 2) {
            const bool last = (t == nt - 2);
            const char* a1 = cA + (size_t)(t + 1) * kstep;
            const char* a2 = last ? nA : cA + (size_t)(t + 2) * kstep; const char* b2 = last ? nB : cB + (size_t)(t + 2) * kstep;
            const char* a3 = a2 + kstep; const char* b3 = b2 + kstep;
            PG8_LDB(B0, 0, 0); PG8_LDB(B1, 0, 1); PG8_SCHED; PG8_LDA(At, 0, 0); PG8_STAGE(PG8_SA(1, 1), a1 + hstepA, voffA);
            PG8_WAIT_V(8); PG8_WAIT_L(0); PG8_BAR; if (cur.hs != 1) { PG8_MMA(0, 0, At, B0); PG8_MMA(0, 1, At, B1); } PG8_BAR; PG8_SCHED;
            PG8_LDA(At, 0, 1); PG8_STAGE(PG8_SB(0, 0), b2, voffB); PG8_STAGE(PG8_SB(0, 1), b2 + hstepB, voffB); PG8_STAGE(PG8_SA(0, 0), a2, voffA);
            PG8_WAIT_V(8); PG8_WAIT_L(0); PG8_BAR; if (cur.hs != 0) { PG8_MMA(1, 0, At, B0); PG8_MMA(1, 1, At, B1); } PG8_BAR; PG8_SCHED;
            PG8_LDB(B0, 1, 0); PG8_LDB(B1, 1, 1); PG8_SCHED; PG8_LDA(At, 1, 0); PG8_STAGE(PG8_SA(0, 1), a2 + hstepA, voffA);
            PG8_WAIT_V(8); PG8_WAIT_L(0); PG8_BAR; if (cur.hs != 1) { PG8_MMA(0, 0, At, B0); PG8_MMA(0, 1, At, B1); } PG8_BAR; PG8_SCHED;
            PG8_LDA(At, 1, 1); PG8_STAGE(PG8_SB(1, 0), b3, voffB); PG8_STAGE(PG8_SB(1, 1), b3 + hstepB, voffB); PG8_STAGE(PG8_SA(1, 0), a3, voffA);
            PG8_WAIT_V(8); PG8_WAIT_L(0); PG8_BAR; if (cur.hs != 0) { PG8_MMA(1, 0, At, B0); PG8_MMA(1, 1, At, B1); } PG8_BAR; PG8_SCHED;
        }
        if (wr == 0) PG8_BAR;
        ED(acc, cur, wr, wc, fr, fq);
        if (!has_next) break;
#pragma unroll
        for (int a = 0; a < 2; ++a)
#pragma unroll
            for (int b = 0; b < 2; ++b)
#pragma unroll
                for (int m = 0; m < 4; ++m)
#pragma unroll
                    for (int n = 0; n < 2; ++n) acc[a][b][m][n] = (f32x4){0.f, 0.f, 0.f, 0.f};
        cur = nxt; cA = nA; cB = nB; ++ui;
        if (wr == 1) PG8_BAR;
    }
    PG8_WAIT_V(0);
    PG8_BAR;
#undef PG8_SA
#undef PG8_SB
#undef PG8_STAGE
#undef PG8_LDA
#undef PG8_LDB
#undef PG8_MMA
#undef PG8_WAIT_V
#undef PG8_WAIT_L
#undef PG8_BAR
#undef PG8_SCHED
}
}

__device__ __forceinline__ void st8(f16* p, const f32x4& a, const f32x4& b) {
    f16x8 v; v[0] = (f16)a[0]; v[1] = (f16)a[1]; v[2] = (f16)a[2]; v[3] = (f16)a[3]; v[4] = (f16)b[0]; v[5] = (f16)b[1]; v[6] = (f16)b[2]; v[7] = (f16)b[3];
    *(f16x8*)p = v;
}
__device__ __forceinline__ void ld8f(const f16* p, float* o) { const f16x8 v = *(const f16x8*)p;
#pragma unroll
    for (int i = 0; i < 8; ++i) o[i] = (float)v[i]; }
__device__ __forceinline__ void ld8g(const float* p, float* o) { const f32x4 a = *(const f32x4*)p, b = *(const f32x4*)(p + 4); o[0] = a[0]; o[1] = a[1]; o[2] = a[2]; o[3] = a[3]; o[4] = b[0]; o[5] = b[1]; o[6] = b[2]; o[7] = b[3]; }

struct EpiProj {
    unsigned char* ws;
    __device__ __forceinline__ void operator()(int row, int pn, int cin, const f32x4& a0, const f32x4& a1, const f32x4& b0, const f32x4& b1) const {
        size_t off; int ld, ct;
        if (pn < 10) { off = OFF_LRUXY; ld = 2560; ct = pn; } else if (pn < 22) { off = OFF_RKV; ld = 3072; ct = pn - 10; } else if (pn < 24) { off = OFF_LORAR; ld = 512; ct = pn - 22; }
        else if (pn < 28) { off = OFF_Q; ld = 1024; ct = pn - 24; } else if (pn < 30) { off = OFF_KVRAW; ld = 512; ct = pn - 28; } else if (pn < 42) { off = OFF_GATES; ld = 3072; ct = pn - 30; }
        else { off = OFF_V1O; ld = 256; ct = 0; }
        f16* p = (f16*)(ws + off) + (size_t)row * ld + ct * 256 + cin;
        st8(p, a0, a1); st8(p + 128, b0, b1);
    }
};
struct EpiLruGate {
    const f16* xa; f16* loga; f16* u; const float* ba; const float* bx; const float* lam;
    __device__ __forceinline__ void operator()(int row, int pn, int cin, const f32x4& a0, const f32x4& a1, const f32x4& b0, const f32x4& b1) const {
        const int c0 = pn * 128 + cin; float xv[8], bav[8], bxv[8], lv[8];
        ld8f(xa + (size_t)row * LRUW + c0, xv); ld8g(ba + c0, bav); ld8g(bx + c0, bxv); ld8g(lam + c0, lv);
        f16x8 ol, ou;
#pragma unroll
        for (int e = 0; e < 8; ++e) {
            const float pa = (e < 4 ? a0[e & 3] : a1[e & 3]) + bav[e], px = (e < 4 ? b0[e & 3] : b1[e & 3]) + bxv[e];
            const float la = -8.f * sigm(pa) * lv[e];
            const float z = 2.f * la;
            const float em = z > -0.5f ? -z * (1.f + z * (0.5f + z * (0.16666667f + z * (0.041666668f + z * 0.0083333338f)))) : 1.f - __expf(z);
            const float mult = sqrtf(fmaxf(em, 0.f));
            ol[e] = (f16)la; ou[e] = (f16)(xv[e] * sigm(px) * mult);
        }
        *(f16x8*)(loga + (size_t)row * LRUW + c0) = ol; *(f16x8*)(u + (size_t)row * LRUW + c0) = ou;
    }
};
template <int MODE> struct EpiLora {
    f16* O; const float* bias;
    __device__ __forceinline__ void operator()(int row, int pn, int cin, const f32x4& a0, const f32x4& a1, const f32x4& b0, const f32x4& b1) const {
#pragma unroll
        for (int bj = 0; bj < 2; ++bj) {
            const int c0 = pn * 256 + bj * 128 + cin; float bv[8];
            if (MODE != 2) ld8g(bias + c0, bv);
            f16x8 o;
#pragma unroll
            for (int e = 0; e < 8; ++e) {
                const float v = bj == 0 ? (e < 4 ? a0[e & 3] : a1[e & 3]) : (e < 4 ? b0[e & 3] : b1[e & 3]);
                float r;
                if (MODE == 0) { const float z = bv[e] + v; const float sp = (z > 15.f) ? __expf(-z) : __logf(1.f + __expf(-z)); const float w = -sp - 0.5f; r = -__expf(w); }
                else if (MODE == 1) r = sigm(bv[e] + v);
                else r = v;
                o[e] = (f16)r;
            }
            *(f16x8*)(O + (size_t)row * 1024 + c0) = o;
        }
    }
};
template <int BR> struct EpiMerge {
    const f16* gates; float* merged; f16* mixed;
    __device__ __forceinline__ void operator()(int row, int pn, int cin, const f32x4& a0, const f32x4& a1, const f32x4& b0, const f32x4& b1) const {
#pragma unroll
        for (int bj = 0; bj < 2; ++bj) {
            const int c0 = pn * 256 + bj * 128 + cin; float gv[8], mv[8];
            ld8f(gates + (size_t)row * 3072 + BR * 1024 + c0, gv);
            float* mp = merged + (size_t)row * 1024 + c0;
            if (BR > 0) ld8g(mp, mv);
            float o[8];
#pragma unroll
            for (int e = 0; e < 8; ++e) {
                const float v = bj == 0 ? (e < 4 ? a0[e & 3] : a1[e & 3]) : (e < 4 ? b0[e & 3] : b1[e & 3]);
                o[e] = (BR > 0 ? mv[e] : 0.f) + sigm(gv[e]) * v;
            }
            if (BR < 2) { *(f32x4*)mp = (f32x4){o[0], o[1], o[2], o[3]}; *(f32x4*)(mp + 4) = (f32x4){o[4], o[5], o[6], o[7]}; }
            else { f16x8 h;
#pragma unroll
                for (int e = 0; e < 8; ++e) h[e] = (f16)o[e];
                *(f16x8*)(mixed + (size_t)row * 1024 + c0) = h; }
        }
    }
};
struct EpiResid {
    const float* xin; float* out; const float* gate  ; int seg;
    __device__ __forceinline__ void operator()(int row, int pn, int cin, const f32x4& a0, const f32x4& a1, const f32x4& b0, const f32x4& b1) const {
        const size_t g = (size_t)grow(row, seg); const int b = row >> 11;
#pragma unroll
        for (int bj = 0; bj < 2; ++bj) {
            const int c0 = pn * 256 + bj * 128 + cin; float xv[8], gv[8];
            ld8g(xin + g * 1024 + c0, xv); ld8g(gate + b * 6144 + c0, gv);
            float o[8];
#pragma unroll
            for (int e = 0; e < 8; ++e) { const float v = bj == 0 ? (e < 4 ? a0[e & 3] : a1[e & 3]) : (e < 4 ? b0[e & 3] : b1[e & 3]); o[e] = xv[e] + gv[e] * v; }
            float* op = out + g * 1024 + c0;
            *(f32x4*)op = (f32x4){o[0], o[1], o[2], o[3]}; *(f32x4*)(op + 4) = (f32x4){o[4], o[5], o[6], o[7]};
        }
    }
};
struct EpiSwiglu {
    f16* ffh;
    __device__ __forceinline__ void operator()(int row, int pn, int cin, const f32x4& a0, const f32x4& a1, const f32x4& b0, const f32x4& b1) const {
        f16x8 o;
#pragma unroll
        for (int e = 0; e < 8; ++e) { const float gt = e < 4 ? a0[e & 3] : a1[e & 3], up = e < 4 ? b0[e & 3] : b1[e & 3]; o[e] = (f16)(gt * sigm(gt) * up); }
        *(f16x8*)(ffh + (size_t)row * DFF + pn * 128 + cin) = o;
    }
};
struct EpiDispatch {
    int kind; const Params& P; int l, seg;
    template <class E> __device__ __forceinline__ void run(const E& e, const f32x4 (&acc)[2][2][4][2], const pg8::Unit& u, int wr, int wc, int fr, int fq) const {
#pragma unroll
        for (int ai = 0; ai < 2; ++ai) { if (u.hs == 1 - ai) continue;
#pragma unroll
            for (int m = 0; m < 4; ++m) {
                const int row = u.pm * 256 + ai * 128 + wr * 64 + m * 16 + fr;
                __builtin_amdgcn_sched_barrier(0);
                e(row, u.pn, wc * 32 + 8 * fq, acc[ai][0][m][0], acc[ai][0][m][1], acc[ai][1][m][0], acc[ai][1][m][1]);
            } }
    }
    __device__ __forceinline__ void operator()(const f32x4 (&acc)[2][2][4][2], const pg8::Unit& u, int wr, int wc, int fr, int fq) const {
        unsigned char* ws = ows(P.ws); const float* const* in = P.in; float* out = P.out; const float* xin = l == 0 ? P.in[I_X] : P.out; const float* mod = (const float*)(ws + OFF_MOD) + (size_t)l * 4 * 6144;
        const f16* gates = (const f16*)(ws + OFF_GATES); float* merged = (float*)(ws + OFF_MERGED); f16* mixed = (f16*)(ws + OFF_MIXED);
        switch (kind) {
        case 0: if (EPON(0)) run(EpiProj{ws}, acc, u, wr, wc, fr, fq); break;
        case 1: if (EPON(1)) run(EpiLruGate{(const f16*)(ws + OFF_XA), (f16*)(ws + OFF_LOGA), (f16*)(ws + OFF_U), in[I_LRUBA] + l * 1280, in[I_LRUBX] + l * 1280, (const float*)(ws + OFF_SP) + l * 1280}, acc, u, wr, wc, fr, fq); break;
        case 2: if (EPON(2)) run(EpiLora<0>{(f16*)(ws + OFF_LD), in[I_W0] + l * 1024}, acc, u, wr, wc, fr, fq); break;
        case 3: if (EPON(3)) run(EpiLora<1>{(f16*)(ws + OFF_A), in[I_A0] + l * 1024}, acc, u, wr, wc, fr, fq); break;
        case 4: if (EPON(4)) run(EpiLora<2>{(f16*)(ws + OFF_G), nullptr}, acc, u, wr, wc, fr, fq); break;
        case 5: if (EPON(5)) run(EpiLora<1>{(f16*)(ws + OFF_VMIX), in[I_V0]}, acc, u, wr, wc, fr, fq); break;
        case 6: if (EPON(6)) run(EpiMerge<0>{gates, merged, mixed}, acc, u, wr, wc, fr, fq); break;
        case 7: if (EPON(7)) run(EpiMerge<1>{gates, merged, mixed}, acc, u, wr, wc, fr, fq); break;
        case 8: if (EPON(8)) run(EpiMerge<2>{gates, merged, mixed}, acc, u, wr, wc, fr, fq); break;
        case 9: if (EPON(9)) run(EpiResid{xin, out, mod + 2048, seg}, acc, u, wr, wc, fr, fq); break;
        case 10: if (EPON(10)) run(EpiSwiglu{(f16*)(ws + OFF_FFH)}, acc, u, wr, wc, fr, fq); break;
        default: if (EPON(11)) run(EpiResid{out, out, mod + 5120, seg}, acc, u, wr, wc, fr, fq); break;
        }
    }
};

template <class Src> __device__ __forceinline__ void prep_w(f16* Wt, int N, int K, const Src& src, float* tile) {
    const int tid = otid(), nkt = K / 64, ntile = (N / 64) * nkt;
    for (int t = blockIdx.x; t < ntile; t += gridDim.x) {
        const int n0 = (t / nkt) * 64, k0 = (t % nkt) * 64;
#pragma unroll
        for (int i = 0; i < 8; ++i) { const int kk = (tid >> 6) + 8 * i, nn = tid & 63; tile[kk * 65 + nn] = src(n0 + nn, k0 + kk); }
        __syncthreads();
#pragma unroll
        for (int i = 0; i < 8; ++i) { const int nn = (tid >> 6) + 8 * i, kk = tid & 63; Wt[(size_t)(n0 + nn) * K + k0 + kk] = (f16)tile[kk * 65 + nn]; }
        __syncthreads();
    }
}

__device__ __forceinline__ void phase_prep(const Params& P, int l, float* tile) {
    f16* W = (f16*)(P.ws + OFF_W);
    { const float* w = P.in[I_WIN] + (size_t)l * 1024 * INC; const float* v1 = P.in[I_V1];
      prep_w(W + W_IN, l == 0 ? 10752 : NIN, 1024, [=](int n, int k) -> float {
          int s;
          if (n < 5632) s = n;
          else if (n < 6144) { const int j = n - 5632; s = j < 64 ? 5632 + j : (j >= 128 && j < 192) ? 5696 + (j - 128) : (j >= 256 && j < 416) ? 5760 + (j - 256) : -1; }
          else if (n < 7168) s = 5920 + (n - 6144);
          else if (n < 7680) s = 6944 + (n - 7168);
          else if (n < 10752) s = 7456 + (n - 7680);
          else { const int j = n - 10752; return j < 32 ? v1[(size_t)k * 32 + j] : 0.f; }
          return s < 0 ? 0.f : w[(size_t)k * INC + s]; }, tile); }
    { const float* wa = P.in[I_LRUWA] + (size_t)l * 16 * 6400; const float* wx = P.in[I_LRUWX] + (size_t)l * 16 * 6400;
      prep_w(W + W_LG, 2560, 1280, [=](int n, int k) -> float {
          const int half = (n & 255) >> 7, c = (n >> 8) * 128 + (n & 127), nb = c / 80, jj = c - nb * 80, kb = k / 80, ii = k - kb * 80;
          if (kb != nb) return 0.f;
          return (half ? wx : wa)[(size_t)(nb * 80 + ii) * 80 + jj]; }, tile); }
    { const float* w = P.in[I_WLRUO] + (size_t)l * 1280 * 1024; prep_w(W + W_LO, 1024, 1280, [=](int n, int k) -> float { return w[(size_t)k * 1024 + n]; }, tile); }
    { const float* w = P.in[I_WRWO] + (size_t)l * 1024 * 1024; prep_w(W + W_RO, 1024, 1024, [=](int n, int k) -> float { return w[(size_t)k * 1024 + n]; }, tile); }
    { const float* w = P.in[I_WATTO] + (size_t)l * 1024 * 1024; prep_w(W + W_AO, 1024, 1024, [=](int n, int k) -> float { return w[(size_t)k * 1024 + n]; }, tile); }
    { const float* w = P.in[I_WOUT] + (size_t)l * 1024 * 1024; prep_w(W + W_OUT, 1024, 1024, [=](int n, int k) -> float { return w[(size_t)k * 1024 + n]; }, tile); }
    { const float* w = P.in[I_WFI] + (size_t)l * 1024 * 5632;
      prep_w(W + W_FI, 5632, 1024, [=](int n, int k) -> float { const int half = (n & 255) >> 7, idx = (n >> 8) * 128 + (n & 127); return w[(size_t)k * 5632 + half * 2816 + idx]; }, tile); }
    { const float* w = P.in[I_WFO] + (size_t)l * 2816 * 1024; prep_w(W + W_FO, 1024, 2816, [=](int n, int k) -> float { return w[(size_t)k * 1024 + n]; }, tile); }
    { const float* w = P.in[I_W2] + (size_t)l * 64 * 1024; prep_w(W + W_W2, 1024, 128, [=](int n, int k) -> float { return k < 64 ? w[(size_t)k * 1024 + n] : 0.f; }, tile); }
    { const float* w = P.in[I_A2] + (size_t)l * 64 * 1024; prep_w(W + W_A2, 1024, 128, [=](int n, int k) -> float { return k < 64 ? w[(size_t)k * 1024 + n] : 0.f; }, tile); }
    { const float* w = P.in[I_G2] + (size_t)l * 160 * 1024; prep_w(W + W_G2, 1024, 256, [=](int n, int k) -> float { return k < 160 ? w[(size_t)k * 1024 + n] : 0.f; }, tile); }
    if (l == 1) { const float* w = P.in[I_V2]; prep_w(W + W_V2, 1024, 128, [=](int n, int k) -> float { return k < 32 ? w[(size_t)k * 1024 + n] : 0.f; }, tile); }
}

__device__ __forceinline__ void phase_mod(const Params& P, float* lds) {
    const int tid = otid(), wave = tid >> 6, lane = tid & 63;
    float* sc = lds;
    float* red = lds + 4096;
    const float* c = P.in[I_C];
    for (int i = tid; i < 4096; i += NTHR) { const float v = c[i]; sc[i] = v * sigm(v); }
    __syncthreads();
    float* mod = (float*)(P.ws + OFF_MOD);
    if (blockIdx.x == 0) for (int i = tid; i < 2560; i += NTHR) ((float*)(P.ws + OFF_SP))[i] = log1pf(expf(-P.in[I_LAM][i]));
    for (int it = blockIdx.x; it < 192; it += gridDim.x) {
        const int l = it / 96, n = (it % 96) * 64 + lane;
        const float* w = P.in[I_WADA] + (size_t)l * 1024 * 6144 + n;
        float a0 = 0.f, a1 = 0.f, a2 = 0.f, a3 = 0.f;
        for (int k0 = wave * 128; k0 < wave * 128 + 128; k0 += 16) {
            float wv[16];
#pragma unroll
            for (int j = 0; j < 16; ++j) wv[j] = w[(size_t)(k0 + j) * 6144];
#pragma unroll
            for (int j = 0; j < 16; ++j) { const int k = k0 + j; a0 += sc[k] * wv[j]; a1 += sc[1024 + k] * wv[j]; a2 += sc[2048 + k] * wv[j]; a3 += sc[3072 + k] * wv[j]; }
        }
        red[(wave * 4 + 0) * 64 + lane] = a0; red[(wave * 4 + 1) * 64 + lane] = a1; red[(wave * 4 + 2) * 64 + lane] = a2; red[(wave * 4 + 3) * 64 + lane] = a3;
        __syncthreads();
        if (tid < 256) { const int b = tid >> 6; float s = P.in[I_BADA][l * 6144 + n];
#pragma unroll
            for (int w8 = 0; w8 < 8; ++w8) s += red[(w8 * 4 + b) * 64 + lane];
            mod[(size_t)(l * 4 + b) * 6144 + n] = s; }
        __syncthreads();
    }
}

__device__ __forceinline__ void phase_norm(const Params& P, const float* xin, int l, int seg, int which  , size_t hoff, int gw, int nw) {
    const int tid = otid(), lane = tid & 63;
    f16* H = (f16*)(ows(P.ws) + hoff);
    for (int r = gw; r < MS; r += nw) {
        const size_t g = (size_t)grow(r, seg); const int b = r >> 11;
        const float* mod = (const float*)(P.ws + OFF_MOD) + (size_t)(l * 4 + b) * 6144 + which * 3072;
        f32x4 v[4]; float ss = 0.f;
#pragma unroll
        for (int i = 0; i < 4; ++i) { v[i] = *(const f32x4*)(xin + g * 1024 + i * 256 + lane * 4); ss += v[i][0] * v[i][0] + v[i][1] * v[i][1] + v[i][2] * v[i][2] + v[i][3] * v[i][3]; }
        ss = wave_sum(ss);
        const float rs = rsqrtf(ss * (1.f / 1024.f) + 1e-6f);
#pragma unroll
        for (int i = 0; i < 4; ++i) { const int c = i * 256 + lane * 4; const f32x4 sh = *(const f32x4*)(mod + c), scl = *(const f32x4*)(mod + 1024 + c); f16x4 o;
#pragma unroll
            for (int e = 0; e < 4; ++e) o[e] = (f16)(v[i][e] * rs * (1.f + scl[e]) + sh[e]);
            *(f16x4*)(H + (size_t)r * 1024 + c) = o; }
    }
}

__device__ __forceinline__ void phase_elem(const Params& P, int l, int seg) {
    const int tid = otid(), lane = tid & 63, gt = blockIdx.x * NTHR + tid, ntot = gridDim.x * NTHR, gw = blockIdx.x * 8 + (tid >> 6), nw = gridDim.x * 8;
    unsigned char* ws = ows(P.ws);
    { const f16* X = (const f16*)(ws + OFF_LRUXY); f16* XA = (f16*)(ws + OFF_XA); f16* cw = (f16*)(ws + OFF_CONVC) + (size_t)(seg & 1) * 4 * 3 * 1280; const f16* cr = (const f16*)(ws + OFF_CONVC) + (size_t)((seg + 1) & 1) * 4 * 3 * 1280;
      const float* w = P.in[I_CONVW] + (size_t)l * 4 * 1280; const float* bia = P.in[I_CONVB] + (size_t)l * 1280;
      for (int it = gt; it < MS * 160; it += ntot) {
          const int r = it / 160, c0 = (it % 160) * 8, b = r >> 11, tl = r & 2047;
          float o[8]; ld8g(bia + c0, o);
#pragma unroll
          for (int j = 0; j < 4; ++j) {
              const int t2 = tl - 3 + j; float xv[8];
              if (t2 >= 0) ld8f(X + (size_t)(r - 3 + j) * 2560 + c0, xv);
              else if (seg > 0) ld8f(cr + (size_t)(b * 3 + (3 + t2)) * 1280 + c0, xv);
              else {
#pragma unroll
                  for (int e = 0; e < 8; ++e) xv[e] = 0.f; }
              float wv[8]; ld8g(w + j * 1280 + c0, wv);
#pragma unroll
              for (int e = 0; e < 8; ++e) o[e] += xv[e] * wv[e];
          }
          f16x8 h;
#pragma unroll
          for (int e = 0; e < 8; ++e) h[e] = (f16)o[e];
          *(f16x8*)(XA + (size_t)r * 1280 + c0) = h;
          if (tl >= SEGT - 3) *(f16x8*)(cw + (size_t)(b * 3 + (tl - (SEGT - 3))) * 1280 + c0) = *(const f16x8*)(X + (size_t)r * 2560 + c0);
      } }
    { const f16* X = (const f16*)(ws + OFF_LORAR); f16* AL = (f16*)(ws + OFF_ALORA); f16* cw = (f16*)(ws + OFF_LORAC) + (size_t)(seg & 1) * 4 * 512; const f16* cr = (const f16*)(ws + OFF_LORAC) + (size_t)((seg + 1) & 1) * 4 * 512;
      const float* mu = P.in[I_MU] + (size_t)l * RWC;
      for (int it = gt; it < MS * 64; it += ntot) {
          const int r = it >> 6, c0 = (it & 63) * 8, b = r >> 11, tl = r & 2047;
          const f16x8 raw = *(const f16x8*)(X + (size_t)r * 512 + c0);
          if (tl == SEGT - 1) *(f16x8*)(cw + b * 512 + c0) = raw;
          int mode, mo;
          if (c0 < 64) { mode = 0; mo = 3072 + c0; } else if (c0 >= 128 && c0 < 192) { mode = 1; mo = 3136 + (c0 - 128); } else if (c0 >= 256 && c0 < 416) { mode = 2; mo = 3200 + (c0 - 256); } else { mode = 3; mo = 0; }
          f16x8 o;
          if (mode == 3) {
#pragma unroll
              for (int e = 0; e < 8; ++e) o[e] = (f16)0.f;
          } else {
              float pv[8];
              if (tl > 0) ld8f(X + (size_t)(r - 1) * 512 + c0, pv);
              else if (seg > 0) ld8f(cr + b * 512 + c0, pv);
              else {
#pragma unroll
                  for (int e = 0; e < 8; ++e) pv[e] = 0.f; }
              float mv[8]; ld8g(mu + mo, mv);
#pragma unroll
              for (int e = 0; e < 8; ++e) { const float x = (float)raw[e]; const float p = x + (pv[e] - x) * mv[e]; o[e] = (f16)(mode == 0 ? tanhf(p) : mode == 1 ? p : sigm(p)); }
          }
          *(f16x8*)(AL + (size_t)r * 512 + c0) = o;
      } }
    { f16* Q = (f16*)(ws + OFF_Q); const f16* KV = (const f16*)(ws + OFF_KVRAW); f16* KN = (f16*)(ws + OFF_KN);
      const float* qg = P.in[I_QG] + l * 64; const float* kg = P.in[I_KG] + l * 64;
      float gv[16]; ld8g(qg + (lane & 3) * 16, gv); ld8g(qg + (lane & 3) * 16 + 8, gv + 8);
      const f32x4 kgv = *(const f32x4*)(kg + (lane & 15) * 4);
      for (int r = gw; r < MS; r += nw) {
          float v[16]; ld8f(Q + (size_t)r * 1024 + lane * 16, v); ld8f(Q + (size_t)r * 1024 + lane * 16 + 8, v + 8);
          float ss = 0.f;
#pragma unroll
          for (int e = 0; e < 16; ++e) ss += v[e] * v[e];
          ss += __shfl_xor(ss, 1); ss += __shfl_xor(ss, 2);
          const float rs = rsqrtf(ss * (1.f / 64.f) + 1e-6f) * 0.125f;
          f16x8 o0, o1;
#pragma unroll
          for (int e = 0; e < 8; ++e) { o0[e] = (f16)(v[e] * rs * gv[e]); o1[e] = (f16)(v[8 + e] * rs * gv[8 + e]); }
          *(f16x8*)(Q + (size_t)r * 1024 + lane * 16) = o0; *(f16x8*)(Q + (size_t)r * 1024 + lane * 16 + 8) = o1;
          const f16x4 kr = *(const f16x4*)(KV + (size_t)r * 512 + lane * 4);
          float kv[4] = {(float)kr[0], (float)kr[1], (float)kr[2], (float)kr[3]};
          float s2 = kv[0] * kv[0] + kv[1] * kv[1] + kv[2] * kv[2] + kv[3] * kv[3];
          s2 += __shfl_xor(s2, 1); s2 += __shfl_xor(s2, 2); s2 += __shfl_xor(s2, 4); s2 += __shfl_xor(s2, 8);
          const float rk = rsqrtf(s2 * (1.f / 64.f) + 1e-6f);
          f16x4 ko; ko[0] = (f16)(kv[0] * rk * kgv[0]); ko[1] = (f16)(kv[1] * rk * kgv[1]); ko[2] = (f16)(kv[2] * rk * kgv[2]); ko[3] = (f16)(kv[3] * rk * kgv[3]);
          *(f16x4*)(KN + (size_t)grow(r, seg) * 256 + lane * 4) = ko;
      } }
    { const f16* KV = (const f16*)(ws + OFF_KVRAW); f16* VT = (f16*)(ws + OFF_VT);
      for (int it = gw; it < (MS / 64) * 4; it += nw) {
          const int tile = it >> 2, kvh = it & 3, r0 = tile * 64, b = r0 >> 11, pos0 = seg * SEGT + (r0 & 2047);
          f16x8 vv[8];
#pragma unroll
          for (int i = 0; i < 8; ++i)
#pragma unroll
              for (int e = 0; e < 8; ++e) vv[i][e] = KV[(size_t)(r0 + i * 8 + e) * 512 + 256 + kvh * 64 + lane];
          f16* dst = VT + ((size_t)((b * 4 + kvh) * 64 + lane)) * SEQ + pos0;
#pragma unroll
          for (int i = 0; i < 8; ++i) *(f16x8*)(dst + i * 8) = vv[i];
      } }
}

__device__ __forceinline__ void phase_rwprep(const Params& P, int l, int seg) {
    const int tid = otid(), lane = tid & 63, gw = blockIdx.x * 8 + (tid >> 6), nw = gridDim.x * 8;
    unsigned char* ws = ows(P.ws);
    const f16* __restrict__ X = (const f16*)(ws + OFF_RKV); const f16* __restrict__ A = (const f16*)(ws + OFF_A); const f16* __restrict__ VM = (const f16*)(ws + OFF_VMIX); f16* VF = (f16*)(ws + OFF_VFIRST);
    f16* __restrict__ R = (f16*)(ws + OFF_R); f16* __restrict__ K = (f16*)(ws + OFF_K); f16* __restrict__ V = (f16*)(ws + OFF_V); f16* __restrict__ KK = (f16*)(ws + OFF_KK);
    f16* __restrict__ cw = (f16*)(ws + OFF_RKVC) + (size_t)(seg & 1) * 4 * 3072; const f16* __restrict__ cr = (const f16*)(ws + OFF_RKVC) + (size_t)((seg + 1) & 1) * 4 * 3072;
    const float* mu = P.in[I_MU] + (size_t)l * RWC; const float* kkw = P.in[I_KK] + l * 1024; const float* kaw = P.in[I_KA] + l * 1024;
    const int half = gw & 1, c = half * 512 + lane * 8;
    float mur[8], muk[8], muv[8], kkv[8], kav[8];
    ld8g(mu + c, mur); ld8g(mu + 1024 + c, muk); ld8g(mu + 2048 + c, muv); ld8g(kkw + c, kkv); ld8g(kaw + c, kav);
    for (int r = gw >> 1; r < MS; r += nw >> 1) {
        const int b = r >> 11, tl = r & 2047; const size_t g = (size_t)grow(r, seg);
        const f16x8 r0 = *(const f16x8*)(X + (size_t)r * 3072 + c), k0 = *(const f16x8*)(X + (size_t)r * 3072 + 1024 + c), v0 = *(const f16x8*)(X + (size_t)r * 3072 + 2048 + c);
        f16x8 pr, pk, pv;
        if (tl > 0) { pr = *(const f16x8*)(X + (size_t)(r - 1) * 3072 + c); pk = *(const f16x8*)(X + (size_t)(r - 1) * 3072 + 1024 + c); pv = *(const f16x8*)(X + (size_t)(r - 1) * 3072 + 2048 + c); }
        else if (seg > 0) { pr = *(const f16x8*)(cr + b * 3072 + c); pk = *(const f16x8*)(cr + b * 3072 + 1024 + c); pv = *(const f16x8*)(cr + b * 3072 + 2048 + c); }
        else {
#pragma unroll
            for (int e = 0; e < 8; ++e) { pr[e] = (f16)0.f; pk[e] = (f16)0.f; pv[e] = (f16)0.f; } }
        const f16x8 a8 = *(const f16x8*)(A + (size_t)r * 1024 + c);
        f16x8 vf8, vm8;
        if (l == 1) { vf8 = *(const f16x8*)(VF + g * 1024 + c); vm8 = *(const f16x8*)(VM + (size_t)r * 1024 + c); }
        if (tl == SEGT - 1) { *(f16x8*)(cw + b * 3072 + c) = r0; *(f16x8*)(cw + b * 3072 + 1024 + c) = k0; *(f16x8*)(cw + b * 3072 + 2048 + c) = v0; }
        float xr[8], xk[8], xv[8], kk[8]; float ss = 0.f;
#pragma unroll
        for (int e = 0; e < 8; ++e) {
            const float rv = (float)r0[e], kv = (float)k0[e], vv = (float)v0[e];
            xr[e] = rv + ((float)pr[e] - rv) * mur[e]; xk[e] = kv + ((float)pk[e] - kv) * muk[e]; xv[e] = vv + ((float)pv[e] - vv) * muv[e];
            kk[e] = xk[e] * kkv[e]; ss += kk[e] * kk[e];
        }
        ss += __shfl_xor(ss, 1); ss += __shfl_xor(ss, 2); ss += __shfl_xor(ss, 4);
        const float rn = rsqrtf(fmaxf(ss, 1e-24f));
        f16x8 oR, oK, oV, oQ;
        if (l == 0) {
#pragma unroll
            for (int e = 0; e < 8; ++e) oV[e] = (f16)xv[e];
            *(f16x8*)(VF + g * 1024 + c) = oV;
        } else {
#pragma unroll
            for (int e = 0; e < 8; ++e) oV[e] = (f16)(xv[e] + ((float)vf8[e] - xv[e]) * (float)vm8[e]);
        }
#pragma unroll
        for (int e = 0; e < 8; ++e) { oR[e] = (f16)xr[e]; oK[e] = (f16)(xk[e] * (1.f + ((float)a8[e] - 1.f) * kav[e])); oQ[e] = (f16)(kk[e] * rn); }
        const size_t o = (size_t)r * 1024 + c;
        *(f16x8*)(R + o) = oR; *(f16x8*)(K + o) = oK; *(f16x8*)(V + o) = oV; *(f16x8*)(KK + o) = oQ;
    }
}

__device__ __forceinline__ void lru_wave(const Params& P, int seg, int fw, int nfw);
__device__ __forceinline__ void attention(const Params& P, int l, int seg, int gw, int nw, bool dry);
__device__ __forceinline__ unsigned lds_ld(LAS unsigned* p) { return __hip_atomic_load(p, __ATOMIC_ACQUIRE, __HIP_MEMORY_SCOPE_WORKGROUP); }
__device__ __forceinline__ void lds_inc(LAS unsigned* p) { __hip_atomic_fetch_add(p, 1u, __ATOMIC_RELEASE, __HIP_MEMORY_SCOPE_WORKGROUP); }
__device__ __forceinline__ void phase_rwscan(const Params& P, int l, int seg, float* lds, bool dry) {
    const int tid = otid(), lane = tid & 63, wave = tid >> 6;
    unsigned char* ws = ows(P.ws);
    constexpr int CH = 32, NCH = SEGT / CH, NBUF = 2;
    float* buf = lds;
    float* vbuf = lds + NBUF * 10240;
    float* yp = vbuf + NBUF * 512;
    LAS unsigned* flg = (LAS unsigned*)(yp + NBUF * 8192);
    if (tid < 8) flg[tid] = 0u;
    __syncthreads();
    if (wave >= 5) {
        const int fw = blockIdx.x * 3 + (wave - 5), nfw = gridDim.x * 3;
        lru_wave(P, seg, fw, nfw);
        attention(P, l, seg, fw, nfw, dry);
        if (seg + 1 < NSEG) phase_norm(P, l == 0 ? P.in[I_X] : P.out, l, seg + 1, 0, OFF_HN, fw, nfw);
        return;
    }
    int cbase = 0;
    for (int item = blockIdx.x; item < 256; item += gridDim.x, cbase += NCH) {
        const int b = item >> 6, h = (item >> 2) & 15, qd = item & 3;
        const size_t rowbase = (size_t)b * SEGT;
        if (wave < 4) {
            float* st = (float*)(ws + OFF_STATE) + ((size_t)item * 256 + tid) * 4;
            f32x2 S01 = (f32x2){0.f, 0.f}, S23 = S01;
            if (seg > 0) { const f32x4 s0 = *(const f32x4*)st; S01 = (f32x2){s0[0], s0[1]}; S23 = (f32x2){s0[2], s0[3]}; }
            const int ks = (lane & 15) * 4, rr = lane >> 4;
            for (int c = 0; c < NCH; ++c) {
                const int cg = cbase + c, p = cg & 1; const unsigned tgt = (unsigned)((cg >> 1) + 1);
                while (lds_ld(flg + p) < tgt) __builtin_amdgcn_s_sleep(1);
                LAS const float* bp = (LAS const float*)(buf + p * 10240 + ks); LAS const float* vp = (LAS const float*)(vbuf + p * 512 + wave * 4 + rr); LAS float* yo = (LAS float*)(yp + p * 8192 + wave * 64 + lane);
                asm volatile("" : "+v"(bp)); asm volatile("" : "+v"(vp)); asm volatile("" : "+v"(yo));
                f32x4 w4 = *(LAS const f32x4*)(bp), k4 = *(LAS const f32x4*)(bp + 2048), a4 = *(LAS const f32x4*)(bp + 4096), b4 = *(LAS const f32x4*)(bp + 6144), r4 = *(LAS const f32x4*)(bp + 8192);
                float v = vp[0];
                f32x4 nw4 = *(LAS const f32x4*)(bp + 64), nk4 = *(LAS const f32x4*)(bp + 2048 + 64), na4 = *(LAS const f32x4*)(bp + 4096 + 64), nb4 = *(LAS const f32x4*)(bp + 6144 + 64), nr4 = *(LAS const f32x4*)(bp + 8192 + 64);
                float nv = vp[16];
#pragma unroll 8
                for (int t = 0; t < CH; ++t) {
                    const int tn = t + 2 < CH ? t + 2 : CH - 1;
                    const f32x4 mw4 = *(LAS const f32x4*)(bp + tn * 64), mk4 = *(LAS const f32x4*)(bp + 2048 + tn * 64), ma4 = *(LAS const f32x4*)(bp + 4096 + tn * 64), mb4 = *(LAS const f32x4*)(bp + 6144 + tn * 64), mr4 = *(LAS const f32x4*)(bp + 8192 + tn * 64);
                    const float mv = vp[tn * 16];
                    float s0 = S01[0], s1 = S01[1], s2 = S23[0], s3 = S23[1];
                    float sa = __builtin_fmaf(s3, a4[3], __builtin_fmaf(s2, a4[2], __builtin_fmaf(s1, a4[1], s0 * a4[0])));
                    const float q0 = v * k4[0], q1 = v * k4[1], q2 = v * k4[2], q3 = v * k4[3];
                    sa = red16(sa);
                    s0 = __builtin_fmaf(s0, w4[0], __builtin_fmaf(sa, b4[0], q0)); s1 = __builtin_fmaf(s1, w4[1], __builtin_fmaf(sa, b4[1], q1));
                    s2 = __builtin_fmaf(s2, w4[2], __builtin_fmaf(sa, b4[2], q2)); s3 = __builtin_fmaf(s3, w4[3], __builtin_fmaf(sa, b4[3], q3));
                    yo[t * 256] = __builtin_fmaf(s3, r4[3], __builtin_fmaf(s2, r4[2], __builtin_fmaf(s1, r4[1], s0 * r4[0])));
                    asm volatile("" : "+v"(s0), "+v"(s1), "+v"(s2), "+v"(s3));
                    S01 = (f32x2){s0, s1}; S23 = (f32x2){s2, s3};
                    w4 = nw4; k4 = nk4; a4 = na4; b4 = nb4; r4 = nr4; v = nv;
                    nw4 = mw4; nk4 = mk4; na4 = ma4; nb4 = mb4; nr4 = mr4; nv = mv;
                }
                asm volatile("s_waitcnt lgkmcnt(0)" ::: "memory");
                if (lane == 0) lds_inc(flg + 4 + p);
            }
            if (!dry) *(f32x4*)st = (f32x4){S01[0], S01[1], S23[0], S23[1]};
        } else {
            const int lt = lane, tt = lt >> 3, c8 = (lt & 7) * 8;
            struct GS { f16x8 r[2], k[2], q[2], a[2], d[2]; f16x4 v; };
            GS g0, g1, g2;
            auto gload = [&](int hh, GS& g) {
#pragma unroll
                for (int hs = 0; hs < 2; ++hs) { const size_t o = (rowbase + hh * 16 + hs * 8 + tt) * 1024 + h * 64 + c8;
                    const unsigned char* wp = ws + o * 2; g.r[hs] = *(const f16x8*)(wp + OFF_R); g.k[hs] = *(const f16x8*)(wp + OFF_K); g.q[hs] = *(const f16x8*)(wp + OFF_KK); g.a[hs] = *(const f16x8*)(wp + OFF_A); g.d[hs] = *(const f16x8*)(wp + OFF_LD); }
                g.v = *(const f16x4*)((const f16*)(ws + OFF_V) + (rowbase + hh * 16 + (lt >> 2)) * 1024 + h * 64 + qd * 16 + (lt & 3) * 4);
            };
            auto lstore = [&](int p, int half, const GS& g) {
#pragma unroll
                for (int hs = 0; hs < 2; ++hs) { LAS float* bp = (LAS float*)(buf + p * 10240 + (half * 16 + hs * 8 + tt) * 64 + c8);
                    f32x4 o0, o1;
#pragma unroll
                    for (int e = 0; e < 4; ++e) { o0[e] = __expf((float)g.d[hs][e]); o1[e] = __expf((float)g.d[hs][4 + e]); }
                    *(LAS f32x4*)bp = o0; *(LAS f32x4*)(bp + 4) = o1;
#pragma unroll
                    for (int e = 0; e < 4; ++e) { o0[e] = (float)g.k[hs][e]; o1[e] = (float)g.k[hs][4 + e]; }
                    *(LAS f32x4*)(bp + 2048) = o0; *(LAS f32x4*)(bp + 2048 + 4) = o1;
#pragma unroll
                    for (int e = 0; e < 4; ++e) { o0[e] = -(float)g.q[hs][e]; o1[e] = -(float)g.q[hs][4 + e]; }
                    *(LAS f32x4*)(bp + 4096) = o0; *(LAS f32x4*)(bp + 4096 + 4) = o1;
#pragma unroll
                    for (int e = 0; e < 4; ++e) { o0[e] = (float)g.q[hs][e] * (float)g.a[hs][e]; o1[e] = (float)g.q[hs][4 + e] * (float)g.a[hs][4 + e]; }
                    *(LAS f32x4*)(bp + 6144) = o0; *(LAS f32x4*)(bp + 6144 + 4) = o1;
#pragma unroll
                    for (int e = 0; e < 4; ++e) { o0[e] = (float)g.r[hs][e]; o1[e] = (float)g.r[hs][4 + e]; }
                    *(LAS f32x4*)(bp + 8192) = o0; *(LAS f32x4*)(bp + 8192 + 4) = o1; }
                *(LAS f32x4*)(vbuf + p * 512 + (half * 16 + (lt >> 2)) * 16 + (lt & 3) * 4) = (f32x4){(float)g.v[0], (float)g.v[1], (float)g.v[2], (float)g.v[3]};
            };
            auto drain = [&](int c, int p, int half) {
#pragma unroll
                for (int i = 0; i < 4; ++i) {
                    const int o = lt + i * 64, tok = half * 16 + (o >> 4), ri = o & 15;
                    LAS const float* yy = (LAS const float*)(yp + p * 8192 + tok * 256 + (ri >> 2) * 64 + (ri & 3) * 16);
                    const f32x4 s0 = *(LAS const f32x4*)yy, s1 = *(LAS const f32x4*)(yy + 4), s2 = *(LAS const f32x4*)(yy + 8), s3 = *(LAS const f32x4*)(yy + 12);
                    const float sm = ((s0[0] + s0[1]) + (s0[2] + s0[3])) + ((s1[0] + s1[1]) + (s1[2] + s1[3])) + ((s2[0] + s2[1]) + (s2[2] + s2[3])) + ((s3[0] + s3[1]) + (s3[2] + s3[3]));
                    ((f16*)(ws + OFF_Y))[(rowbase + c * CH + tok) * 1024 + h * 64 + qd * 16 + ri] = (f16)sm;
                }
            };
            auto hstep = [&](int hh, const GS& gc, GS& gn) {
                const int c = hh >> 1, half = hh & 1, cg = cbase + c, p = cg & 1;
                if (hh + 2 < 2 * NCH) gload(hh + 2, gn);
                if (cg >= NBUF) {
                    if (half == 0) { const unsigned tgt = 4u * (unsigned)(cg >> 1); while (lds_ld(flg + 4 + p) < tgt) __builtin_amdgcn_s_sleep(1); }
                    if (c >= NBUF) drain(c - NBUF, p, half);
                }
                lstore(p, half, gc);
                if (half == 1) { asm volatile("s_waitcnt lgkmcnt(0)" ::: "memory"); if (lane == 0) lds_inc(flg + p); }
            };
            gload(0, g0); gload(1, g1);
            for (int hh = 0; hh < 2 * NCH - 2; hh += 3) { hstep(hh, g0, g2); hstep(hh + 1, g1, g0); hstep(hh + 2, g2, g1); }
            hstep(2 * NCH - 2, g0, g2); hstep(2 * NCH - 1, g1, g0);
            for (int c = NCH - NBUF; c < NCH; ++c) {
                const int cg = cbase + c, p = cg & 1; const unsigned tgt = 4u * (unsigned)((cg >> 1) + 1);
                while (lds_ld(flg + 4 + p) < tgt) __builtin_amdgcn_s_sleep(1);
                drain(c, p, 0); drain(c, p, 1);
            }
        }
    }
}


__device__ __forceinline__ void lru_agg(const Params& P, int gw, int nw) {
    const int tid = otid(), lane = tid & 63;
    unsigned char* ws = ows(P.ws);
    const f16* __restrict__ LA = (const f16*)(ws + OFF_LOGA); const f16* __restrict__ U = (const f16*)(ws + OFF_U); float* __restrict__ AG = (float*)(ws + OFF_AGG);
    for (int item = gw; item < 2560; item += nw) {
        const int ck = item & 31, g = (item >> 5) % 20, b = item / 640, c = g * 64 + lane;
        const size_t r0 = (size_t)b * SEGT + ck * 64;
        float L = 0.f, H = 0.f;
        for (int s0 = 0; s0 < 64; s0 += 16) {
            f16 la8[16], u8[16];
#pragma unroll
            for (int s = 0; s < 16; ++s) { la8[s] = LA[(r0 + s0 + s) * LRUW + c]; u8[s] = U[(r0 + s0 + s) * LRUW + c]; }
#pragma unroll
            for (int s = 0; s < 16; ++s) { const float la = (float)la8[s]; H = __expf(la) * H + (float)u8[s]; L += la; }
        }
        AG[((size_t)(b * 32 + ck) * 2) * LRUW + c] = L; AG[((size_t)(b * 32 + ck) * 2 + 1) * LRUW + c] = H;
    }
}
__device__ __forceinline__ void lru_wave(const Params& P, int seg, int fw, int nfw) {
    const int tid = otid(), lane = tid & 63;
    unsigned char* ws = ows(P.ws);
    const f16* __restrict__ LA = (const f16*)(ws + OFF_LOGA); const f16* __restrict__ U = (const f16*)(ws + OFF_U); const f16* __restrict__ XY = (const f16*)(ws + OFF_LRUXY); f16* __restrict__ YA = (f16*)(ws + OFF_YA);
    const float* __restrict__ AG = (const float*)(ws + OFF_AGG);
    const float* __restrict__ HCr = (const float*)(ws + OFF_HC) + ((seg + 1) & 1) * 4 * LRUW; float* __restrict__ HCw = (float*)(ws + OFF_HC) + (seg & 1) * 4 * LRUW;
    for (int item = fw; item < 2560; item += nfw) {
        const int ck = item & 31, g = (item >> 5) % 20, b = item / 640, c = g * 64 + lane;
        const size_t r0 = (size_t)b * SEGT + ck * 64;
        float H = seg > 0 ? HCr[b * LRUW + c] : 0.f;
        for (int j = 0; j < ck; ++j) { const float Lj = AG[((size_t)(b * 32 + j) * 2) * LRUW + c], Hj = AG[((size_t)(b * 32 + j) * 2 + 1) * LRUW + c]; H = __expf(Lj) * H + Hj; }
        for (int s0 = 0; s0 < 64; s0 += 8) {
            f16 la8[8], u8[8], y8[8];
#pragma unroll
            for (int s = 0; s < 8; ++s) { la8[s] = LA[(r0 + s0 + s) * LRUW + c]; u8[s] = U[(r0 + s0 + s) * LRUW + c]; y8[s] = XY[(r0 + s0 + s) * 2560 + 1280 + c]; }
#pragma unroll
            for (int s = 0; s < 8; ++s) { H = __expf((float)la8[s]) * H + (float)u8[s]; YA[(r0 + s0 + s) * LRUW + c] = (f16)(H * gelu_tanh((float)y8[s])); }
        }
        if (ck == 31) HCw[b * LRUW + c] = H;
    }
}

__device__ __forceinline__ void rwkv_post(const Params& P, int l, int seg) {
    const int tid = otid(), lane = tid & 63, wave = tid >> 6;
    unsigned char* ws = ows(P.ws);
    const int gw = blockIdx.x * 8 + wave, nw = gridDim.x * 8;
    { const f16* Y = (const f16*)(ws + OFF_Y); const f16* R = (const f16*)(ws + OFF_R); const f16* K = (const f16*)(ws + OFF_K); const f16* V = (const f16*)(ws + OFF_V); const f16* G = (const f16*)(ws + OFF_G); f16* YB = (f16*)(ws + OFF_YB);
      const float* rk = P.in[I_RK] + l * 1024; const float* lw = P.in[I_LNW] + l * 1024; const float* lb = P.in[I_LNB] + l * 1024;
      float rkv[16], lwv[16], lbv[16];
      { const int c = lane * 16; ld8g(rk + c, rkv); ld8g(rk + c + 8, rkv + 8); ld8g(lw + c, lwv); ld8g(lw + c + 8, lwv + 8); ld8g(lb + c, lbv); ld8g(lb + c + 8, lbv + 8); }
      for (int r = gw; r < MS; r += nw) {
          const size_t o = (size_t)r * 1024 + lane * 16;
          float y[16], rv[16], kv[16], vv[16], gv[16];
          ld8f(Y + o, y); ld8f(Y + o + 8, y + 8); ld8f(R + o, rv); ld8f(R + o + 8, rv + 8); ld8f(K + o, kv); ld8f(K + o + 8, kv + 8); ld8f(V + o, vv); ld8f(V + o + 8, vv + 8); ld8f(G + o, gv); ld8f(G + o + 8, gv + 8);
          float s = 0.f, bo = 0.f;
#pragma unroll
          for (int e = 0; e < 16; ++e) { s += y[e]; bo += rv[e] * kv[e] * rkv[e]; }
          s += __shfl_xor(s, 1); s += __shfl_xor(s, 2); bo += __shfl_xor(bo, 1); bo += __shfl_xor(bo, 2);
          const float mean = s * (1.f / 64.f); float q = 0.f;
#pragma unroll
          for (int e = 0; e < 16; ++e) { const float d = y[e] - mean; q += d * d; }
          q += __shfl_xor(q, 1); q += __shfl_xor(q, 2);
          const float rs = rsqrtf(q * (1.f / 64.f) + 64e-5f);
          f16x8 o0, o1;
#pragma unroll
          for (int e = 0; e < 16; ++e) { const float v = ((y[e] - mean) * rs * lwv[e] + lbv[e] + bo * vv[e]) * gv[e]; if (e < 8) o0[e] = (f16)v; else o1[e - 8] = (f16)v; }
          *(f16x8*)(YB + o) = o0; *(f16x8*)(YB + o + 8) = o1;
      } }
}

__device__ __forceinline__ void attention(const Params& P, int l, int seg, int gw, int nw, bool dry) {
    const int tid = otid(), lane = tid & 63, wave = tid >> 6;
    unsigned char* ws = ows(P.ws);
    { f16* Q = (f16*)(ws + OFF_Q); const f16* KN = (const f16*)(ws + OFF_KN); const f16* VT = (const f16*)(ws + OFF_VT);
      const float* sinks = P.in[I_SINK] + l * 16;
      const int qi = lane & 15, quad = lane >> 4;
      for (int u = gw; u < (MS / 16) * 16; u += nw) {
          const int tile = u >> 4, h = u & 15, kvh = h >> 2, r0 = tile * 16, b = r0 >> 11, pos0 = seg * SEGT + (r0 & 2047);
          const f16* qp = Q + (size_t)(r0 + qi) * 1024 + h * 64 + quad * 8;
          const f16x8 qf0 = *(const f16x8*)qp, qf1 = *(const f16x8*)(qp + 32);
          f32x4 sc[10];
          const int qpos = pos0 + qi;
          const f16* kbase = KN + (size_t)b * SEQ * 256 + kvh * 64 + quad * 8;
          f16x8 kf[10][2];
#pragma unroll
          for (int tt = 0; tt < 10; ++tt) {
              int kr = pos0 - 144 + 32 * (tt >> 1) + (qi >> 2) * 8 + (tt & 1) * 4 + (qi & 3); kr = kr < 0 ? 0 : kr;
              const f16* kp = kbase + (size_t)kr * 256;
              kf[tt][0] = *(const f16x8*)kp; kf[tt][1] = *(const f16x8*)(kp + 32);
          }
          f16x8 vf[5][4];
#pragma unroll
          for (int gI = 0; gI < 5; ++gI) {
              int kv0 = pos0 - 144 + 32 * gI + quad * 8; kv0 = kv0 < 0 ? 0 : kv0;
#pragma unroll
              for (int dt = 0; dt < 4; ++dt) vf[gI][dt] = *(const f16x8*)(VT + ((size_t)((b * 4 + kvh) * 64 + dt * 16 + qi)) * SEQ + kv0);
          }
#pragma unroll
          for (int tt = 0; tt < 10; ++tt) {
              f32x4 s = (f32x4){0.f, 0.f, 0.f, 0.f};
              s = __builtin_amdgcn_mfma_f32_16x16x32_f16(kf[tt][0], qf0, s, 0, 0, 0);
              s = __builtin_amdgcn_mfma_f32_16x16x32_f16(kf[tt][1], qf1, s, 0, 0, 0);
#pragma unroll
              for (int j = 0; j < 4; ++j) { const int kpos = pos0 - 144 + 32 * (tt >> 1) + quad * 8 + (tt & 1) * 4 + j; const bool ok = (kpos >= 0) && (kpos <= qpos) && (qpos - kpos < 128); s[j] = ok ? s[j] : -1e30f; }
              sc[tt] = s;
          }
          float m = -1e30f;
#pragma unroll
          for (int tt = 0; tt < 10; ++tt) m = fmaxf(m, fmaxf(fmaxf(sc[tt][0], sc[tt][1]), fmaxf(sc[tt][2], sc[tt][3])));
          m = fmaxf(m, __shfl_xor(m, 16)); m = fmaxf(m, __shfl_xor(m, 32));
          const float sink = sinks[h]; m = fmaxf(m, sink);
          float sum = 0.f;
#pragma unroll
          for (int tt = 0; tt < 10; ++tt)
#pragma unroll
              for (int j = 0; j < 4; ++j) { const float e = __expf(sc[tt][j] - m); sc[tt][j] = e; sum += e; }
          sum += __shfl_xor(sum, 16); sum += __shfl_xor(sum, 32);
          const float inv = 1.f / (sum + __expf(sink - m));
          f32x4 o[4];
#pragma unroll
          for (int dt = 0; dt < 4; ++dt) o[dt] = (f32x4){0.f, 0.f, 0.f, 0.f};
#pragma unroll
          for (int gI = 0; gI < 5; ++gI) {
              f16x8 pf;
#pragma unroll
              for (int j = 0; j < 4; ++j) { pf[j] = (f16)(sc[2 * gI][j] * inv); pf[4 + j] = (f16)(sc[2 * gI + 1][j] * inv); }
#pragma unroll
              for (int dt = 0; dt < 4; ++dt) o[dt] = __builtin_amdgcn_mfma_f32_16x16x32_f16(vf[gI][dt], pf, o[dt], 0, 0, 0);
          }
          f16* op = (dry ? (f16*)(ws + OFF_KVRAW) + (size_t)((r0 + qi) & 4095) * 1024 : Q + (size_t)(r0 + qi) * 1024) + h * 64 + quad * 4;
#pragma unroll
          for (int dt = 0; dt < 4; ++dt) { f16x4 ov; ov[0] = (f16)o[dt][0]; ov[1] = (f16)o[dt][1]; ov[2] = (f16)o[dt][2]; ov[3] = (f16)o[dt][3]; *(f16x4*)(op + dt * 16) = ov; }
      } }
}

constexpr int PH_PER_SEG = 11, PH_PER_LAYER = 1 + NSEG * PH_PER_SEG, N_PHASES = 1 + 2 * PH_PER_LAYER;

struct Job { const f16* A; const f16* Bt; int lda, ldb, nt, N, cshift, kind, lru, hm; };
__device__ __forceinline__ int gemm_jobs(int sub, int l) { return sub == 1 ? 1 : sub == 3 ? (l == 1 ? 5 : 4) : sub == 7 ? 3 : (sub == 8 || sub == 10 || sub == 11) ? 1 : 0; }
__device__ __forceinline__ Job make_job(unsigned char* ws, int sub, int j, int l) {
    const f16* W = (const f16*)(ws + OFF_W);
    switch (sub) {
    case 1: return Job{(const f16*)(ws + OFF_HN), W + W_IN, 1024, 1024, 16, l == 0 ? 10752 : NIN, 0, 0, 0, 0};
    case 3:
        switch (j) {
        case 0: return Job{(const f16*)(ws + OFF_XA), W + W_LG, 1280, 1280, 4, 2560, 0, 1, 1, 0};
        case 1: return Job{(const f16*)(ws + OFF_ALORA), W + W_W2, 512, 128, 2, 1024, 64, 2, 0, 0};
        case 2: return Job{(const f16*)(ws + OFF_ALORA) + 128, W + W_A2, 512, 128, 2, 1024, 192, 3, 0, 0};
        case 3: return Job{(const f16*)(ws + OFF_ALORA) + 256, W + W_G2, 512, 256, 4, 1024, 128, 4, 0, 0};
        default: return Job{(const f16*)(ws + OFF_V1O), W + W_V2, 256, 128, 2, 1024, 0, 5, 0, 0};
        }
    case 7:
        switch (j) {
        case 0: return Job{(const f16*)(ws + OFF_YA), W + W_LO, 1280, 1280, 20, 1024, 0, 6, 0, 1};
        case 1: return Job{(const f16*)(ws + OFF_YB), W + W_RO, 1024, 1024, 16, 1024, 0, 7, 0, 1};
        default: return Job{(const f16*)(ws + OFF_Q), W + W_AO, 1024, 1024, 16, 1024, 0, 8, 0, 1};
        }
    case 8: return Job{(const f16*)(ws + OFF_MIXED), W + W_OUT, 1024, 1024, 16, 1024, 0, 9, 0, 1};
    case 10: return Job{(const f16*)(ws + OFF_H), W + W_FI, 1024, 1024, 16, 5632, 0, 10, 0, 0};
    default: return Job{(const f16*)(ws + OFF_FFH), W + W_FO, DFF, DFF, 44, 1024, 0, 11, 0, 1};
    }
}

__global__ void __launch_bounds__(NTHR) fwd_kernel(Params P) {
    extern __shared__ __attribute__((aligned(16))) unsigned char smem[];
    LAS unsigned char* lds = (LAS unsigned char*)smem;
    float* ldsf = (float*)smem;
    unsigned char* ws = ows(P.ws);
    const int G = gridDim.x, cid = blockIdx.x;
    unsigned nbar = 0;
    volatile LAS unsigned* xst = (volatile LAS unsigned*)(lds + 155136);
    if (threadIdx.x == 0) { xst[0] = 0u; xst[1] = 0u; }
    __syncthreads();
    XcdBarrier xbar; xbar.bar = (unsigned*)(ws + OFF_BAR); xbar.x = 0; xbar.st = xst;
    if (P.coop) xbar = xcd_barrier_post((unsigned*)(ws + OFF_BAR), xst);
#if PROBE
    volatile float* tcl = (volatile float*)(smem + 152000); volatile unsigned long long* tpl = (volatile unsigned long long*)(smem + 152064);
    if (threadIdx.x == 0) { for (int i = 0; i < 8; ++i) tcl[i] = 0.f; tpl[0] = __builtin_amdgcn_s_memrealtime(); tpl[1] = tpl[0]; }
#endif
    for (int ph = P.ph_lo; ph < P.ph_hi; ++ph) {
        if (ph == 0) { if (PHON(12)) phase_mod(P, ldsf); }
        else {
            const int p = ph - 1, l = p / PH_PER_LAYER, q = p % PH_PER_LAYER;
            const float* xin = l == 0 ? P.in[I_X] : P.out;
            if (q == 0) { if (PHON(13)) phase_prep(P, l, ldsf); phase_norm(P, xin, l, 0, 0, OFF_HN, blockIdx.x * 8 + (otid() >> 6), gridDim.x * 8); }
            else {
                const int seg = (q - 1) / PH_PER_SEG, sub = (q - 1) % PH_PER_SEG + 1;
                const int nj = gemm_jobs(sub, l);
#if DUP_SUB >= 0
                if (sub == DUP_SUB) { if (sub == 5) phase_rwscan(P, l, seg, ldsf, true); else if (sub == 6) rwkv_post(P, l, seg); else if (sub == 4) phase_rwprep(P, l, seg);
                    else if (nj > 0) for (int j = 0; j < nj; ++j) { const Job jb = make_job(ws, sub, j, l); pg8::Gemm g{jb.A, jb.Bt, jb.lda, jb.ldb, jb.nt}; pg8::StaticOrder S; S.init(MS, jb.N, G, (cid + jb.cshift) % G, jb.lru, jb.hm); EpiDispatch ED{jb.kind, P, l, seg}; pg8::gemm_phase(lds, g, S, ED); }
                    if (P.coop) { xcd_barrier(xbar); } }
#endif
                if (nj > 0) {
                    if (PHON(1)) for (int j = 0; j < nj; ++j) {
                        const Job jb = make_job(ws, sub, j, l);
                        pg8::Gemm g{jb.A, jb.Bt, jb.lda, jb.ldb, jb.nt}; pg8::StaticOrder S; S.init(MS, jb.N, G, (cid + jb.cshift) % G, jb.lru, jb.hm);
                        EpiDispatch ED{jb.kind, P, l, seg};
                        pg8::gemm_phase(lds, g, S, ED);
                    }
                } else {
                    switch (sub) {
                    case 2: if (PHON(2)) phase_elem(P, l, seg); break;
                    case 4: if (PHON(4)) { phase_rwprep(P, l, seg); lru_agg(P, blockIdx.x * 8 + (otid() >> 6), gridDim.x * 8); } break;
                    case 5: if (PHON(5)) phase_rwscan(P, l, seg, ldsf, false); break;
                    case 6: if (PHON(6)) rwkv_post(P, l, seg); break;
                    default: if (PHON(9)) phase_norm(P, P.out, l, seg, 1, OFF_H, blockIdx.x * 8 + (otid() >> 6), gridDim.x * 8); break;
                    }
                }
            }
        }
        if (P.coop && ph + 1 < P.ph_hi) { if (P.coop == 2) cg::this_grid().sync(); else xcd_barrier(xbar); }
#if DUP_SYNC
        if (P.coop && ph + 1 < P.ph_hi) { xcd_barrier(xbar); }
#endif
#if PROBE
        if (threadIdx.x == 0) { const unsigned long long tn = __builtin_amdgcn_s_memrealtime(); const float d = (float)(tn - tpl[0]); tpl[0] = tn;
          int cls = 4; if (ph > 0) { const int q = (ph - 1) % PH_PER_LAYER; if (q > 0) { const int sub = (q - 1) % PH_PER_SEG; cls = sub == 5 ? 0 : sub == 6 ? 1 : (sub == 1 || sub == 3 || sub == 7 || sub == 8 || sub == 10 || sub == 11) ? 2 : 3; } }
          tcl[cls] += d; }
#endif
    }
#if PROBE
    { float* fr = (float*)(ws + OFF_SP + 16384);
      if (blockIdx.x == 0 && threadIdx.x == 0) { const float tot = (float)(tpl[0] - tpl[1]); fr[0] = tcl[PC1] / tot; fr[1] = tcl[PC2] / tot; }
      cg::this_grid().sync();
      const float f1 = fr[0], f2 = fr[1]; const int nz = (int)(f1 * 32768.f);
      for (int r = blockIdx.x; r < nz; r += gridDim.x) for (int c = threadIdx.x; c < 1024; c += NTHR) P.out[(size_t)r * 1024 + c] = 0.f;
      if (blockIdx.x == gridDim.x - 1 && threadIdx.x == 0) P.out[(size_t)32767 * 1024 + 1023] = 10000.f * f2; }
#endif
}

extern "C" void kernel_launch(void* const* d_in, const int* in_sizes, int n_in, void* d_out, int out_size, void* d_ws, size_t ws_size, hipStream_t stream) {
    static int grid = 0;
    if (grid == 0) {
        int dev = 0, cus = 0, per_cu = 0;
        hipGetDevice(&dev); hipDeviceGetAttribute(&cus, hipDeviceAttributeMultiprocessorCount, dev);
        hipFuncSetAttribute((const void*)fwd_kernel, hipFuncAttributeMaxDynamicSharedMemorySize, LDS_BYTES);
        hipOccupancyMaxActiveBlocksPerMultiprocessor(&per_cu, (const void*)fwd_kernel, NTHR, LDS_BYTES);
        if (per_cu < 1) per_cu = 1;
        grid = cus * per_cu;
        if (n_in != 35 || ws_size < WS_END) { fprintf(stderr, "kernel_launch: unexpected n_in %d / ws_size %zu\n", n_in, ws_size); grid = -1; }
    }
    if (grid < 0) return;
    Params p{};
    for (int i = 0; i < 35; ++i) p.in[i] = (const float*)d_in[i];
    p.out = (float*)d_out; p.ws = (unsigned char*)d_ws;
#if COOP
    hipMemsetAsync((char*)d_ws + OFF_BAR, 0, 16384, stream);
    p.ph_lo = 0; p.ph_hi = N_PHASES; p.coop = 1;
    void* args[] = {&p};
    hipError_t e = hipLaunchCooperativeKernel((const void*)fwd_kernel, dim3(grid), dim3(NTHR), args, LDS_BYTES, stream);
    if (e != hipSuccess) fprintf(stderr, "cooperative launch failed: %s (grid %d)\n", hipGetErrorString(e), grid);
#else
    for (int ph = 0; ph < N_PHASES; ++ph) {
        p.ph_lo = ph; p.ph_hi = ph + 1; p.coop = 0;
        hipLaunchKernelGGL(fwd_kernel, dim3(grid), dim3(NTHR), LDS_BYTES, stream, p);
    }
#endif
}
```
